# Optimizing an MI355X kernel written in HIP

```python
import math
import jax
import jax.numpy as jnp
from jax import lax
import numpy as np


D_MODEL = 2048
BATCH = 4
SEQ = 4096
DEPTH = 2

CTX_LEN = 256
GRID_W = 64
N_EVEN = (DEPTH + 1) // 2
N_ODD = DEPTH // 2
DEEPNORM_ALPHA = (2 * DEPTH) ** 0.25
DEEPNORM_BETA = (8 * DEPTH) ** -0.25
NORM_EPS = 1e-6
N_MOD = 6

S5_WIDTH = D_MODEL // 2
S5_GROUP = 16
S5_GROUPS = S5_WIDTH // S5_GROUP
S5_STATE = 64
S5_DT_MIN = 1e-3
S5_DT_MAX = 1e-1

DN_WIDTH = D_MODEL // 2
DN_HEAD_DIM = 128
DN_HEADS = DN_WIDTH // DN_HEAD_DIM
DN_CHUNK = 64
DN_CONV = 3
DN_DT_MIN = 1e-3
DN_DT_MAX = 1e-1

EVEN_COLS = (3 * DN_WIDTH, DN_WIDTH, S5_WIDTH, S5_WIDTH, 2 * DN_HEADS, 2 * DN_HEADS)
EVEN_IN = sum(EVEN_COLS)
EVEN_MIX = S5_WIDTH + DN_WIDTH

GLA_HEADS = 4
GLA_KEY_WIDTH = D_MODEL // 2
GLA_VAL_WIDTH = D_MODEL
GLA_DK = GLA_KEY_WIDTH // GLA_HEADS
GLA_DV = GLA_VAL_WIDTH // GLA_HEADS
GLA_RANK = 16
GLA_TAU = 16.0
GLA_CHUNK = 16
ODD_COLS = (GLA_KEY_WIDTH, GLA_KEY_WIDTH, GLA_VAL_WIDTH, GLA_VAL_WIDTH, 2 * GLA_RANK)
ODD_IN = sum(ODD_COLS)

FFN_HIDDEN = 5632
N_EXPERTS = 8
TOP_K = 2
EXPERT_HIDDEN = 7168
MOE_BLOCK = 512

F32 = jnp.float32

kernel_name = 'hybrid_s5_deltanet_gla_moe_dit'


def _cuts(cols):
    return np.cumsum(cols)[:-1].tolist()


def layer_norm(x, g, b):
    xf = x.astype(F32)
    mu = jnp.mean(xf, axis=-1, keepdims=True)
    var = jnp.mean(jnp.square(xf - mu), axis=-1, keepdims=True)
    return ((xf - mu) * lax.rsqrt(var + NORM_EPS) * g.astype(F32) + b.astype(F32)).astype(x.dtype)


def rms_norm(x, w):
    xf = x.astype(F32)
    return xf * lax.rsqrt(jnp.mean(jnp.square(xf), axis=-1, keepdims=True) + NORM_EPS) * w.astype(F32)


def l2_normalize(x):
    return x * lax.rsqrt(jnp.sum(jnp.square(x), axis=-1, keepdims=True) + NORM_EPS)


def modulate(h, shift, scale):
    return h * (1.0 + scale) + shift


def adaln(cond, w, b):
    return jnp.split(jax.nn.silu(cond) @ w + b, N_MOD, axis=-1)


def swiglu(h, w1, w3, w2):
    return (jax.nn.silu(h @ w1) * (h @ w3)) @ w2


def to_chunks(t, size):
    b, n = t.shape[0], t.shape[1]
    t = t.reshape((b, n // size, size) + t.shape[2:])
    return jnp.moveaxis(t, 3, 1)


def from_chunks(o):
    n, b, h, c, d = o.shape
    return jnp.transpose(o, (1, 0, 3, 2, 4)).reshape(b, n * c, h, d)


def run_bidirectional(rule, shared_x, shared_c, dirs_x, dirs_c, s0, need_ctx):
    outs_x, outs_c = [], []
    for d in range(2):
        flip = (lambda t: jnp.flip(t, axis=1)) if d == 1 else (lambda t: t)
        o_c, s_c = rule(*[flip(t) for t in shared_c + dirs_c[d]], s0)
        o_x, _ = rule(*[flip(t) for t in shared_x + dirs_x[d]], s_c)
        outs_x.append(flip(o_x))
        outs_c.append(flip(o_c))
    y_c = outs_c[0] + outs_c[1] if need_ctx else None
    return outs_x[0] + outs_x[1], y_c


def s5_discretize(lam_re, lam_im, log_step, b_re, b_im):
    delta = jnp.exp(log_step)[:, None]
    mag = jnp.exp(lam_re * delta)
    a_re = mag * jnp.cos(lam_im * delta)
    a_im = mag * jnp.sin(lam_im * delta)
    den = jnp.square(lam_re) + jnp.square(lam_im)
    f_re = ((a_re - 1.0) * lam_re + a_im * lam_im) / den
    f_im = (a_im * lam_re - (a_re - 1.0) * lam_im) / den
    bb_re = f_re[..., None] * b_re - f_im[..., None] * b_im
    bb_im = f_re[..., None] * b_im + f_im[..., None] * b_re
    return a_re, a_im, bb_re, bb_im


def linear_recurrence_combine(e1, e2):
    a1r, a1i, h1r, h1i = e1
    a2r, a2i, h2r, h2i = e2
    return (a2r * a1r - a2i * a1i, a2r * a1i + a2i * a1r,
            a2r * h1r - a2i * h1i + h2r, a2r * h1i + a2i * h1r + h2i)


def s5_states(u, a_re, a_im, bb_re, bb_im, h0, reverse):
    bu_re = jnp.einsum('btgh,gph->tbgp', u, bb_re)
    bu_im = jnp.einsum('btgh,gph->tbgp', u, bb_im)
    shape = (u.shape[1], 1) + a_re.shape
    ac_re, ac_im, h_re, h_im = lax.associative_scan(
        linear_recurrence_combine,
        (jnp.broadcast_to(a_re, shape), jnp.broadcast_to(a_im, shape), bu_re, bu_im),
        reverse=reverse, axis=0)
    if h0 is not None:
        h0_re, h0_im = h0
        h_re = h_re + ac_re * h0_re - ac_im * h0_im
        h_im = h_im + ac_re * h0_im + ac_im * h0_re
    return h_re, h_im


def s5_readout(h_re, h_im, c_re, c_im):
    return jnp.einsum('tbgp,ghp->btgh', h_re, c_re) - jnp.einsum('tbgp,ghp->btgh', h_im, c_im)


def s5_mixer(u_x, u_c, gate_x, gate_c, lam_re, lam_im, log_step, b_re, b_im, c_re, c_im, d_skip, need_ctx):
    lam_re, lam_im, log_step, b_re, b_im, c_re, c_im = [
        t.astype(F32) for t in (lam_re, lam_im, log_step, b_re, b_im, c_re, c_im)]

    def groups(u):
        return u.astype(F32).reshape(u.shape[0], u.shape[1], S5_GROUPS, S5_GROUP)

    ux, uc = groups(u_x), groups(u_c)
    ys_x, ys_c = [], []
    for d in range(2):
        rev = d == 1
        a_re, a_im, bb_re, bb_im = s5_discretize(lam_re[d], lam_im[d], log_step[d], b_re[d], b_im[d])
        hc_re, hc_im = s5_states(uc, a_re, a_im, bb_re, bb_im, None, rev)
        last = 0 if rev else -1
        hx_re, hx_im = s5_states(ux, a_re, a_im, bb_re, bb_im, (hc_re[last], hc_im[last]), rev)
        ys_x.append(s5_readout(hx_re, hx_im, c_re[d], c_im[d]))
        if need_ctx:
            ys_c.append(s5_readout(hc_re, hc_im, c_re[d], c_im[d]))

    def glu_out(y, u, gate):
        y = (y + d_skip.astype(F32).reshape(S5_GROUPS, S5_GROUP) * u).reshape(u.shape[0], u.shape[1], S5_WIDTH)
        return (jax.nn.gelu(y) * jax.nn.sigmoid(gate.astype(F32))).astype(gate.dtype)

    y_x = glu_out(ys_x[0] + ys_x[1], ux, gate_x)
    y_c = glu_out(ys_c[0] + ys_c[1], uc, gate_c) if need_ctx else None
    return y_x, y_c


def depthwise_conv2d(x, w, rows):
    b, n, ch = x.shape
    y = lax.conv_general_dilated(x.reshape(b, rows, GRID_W, ch), w[:, :, None, :], window_strides=(1, 1),
                                 padding='SAME', dimension_numbers=('NHWC', 'HWIO', 'NHWC'),
                                 feature_group_count=ch)
    return y.reshape(b, n, ch)


def depthwise_conv1d(x, w):
    ch = x.shape[-1]
    return lax.conv_general_dilated(x, w[:, None, :], window_strides=(1,), padding='SAME',
                                    dimension_numbers=('NWC', 'WIO', 'NWC'), feature_group_count=ch)


def gated_delta_rule(q, k, v, beta, g, s0):
    dv = v.shape[-1]
    q, k, v, beta, g = (to_chunks(t, DN_CHUNK) for t in (q, k, v, beta, g))
    gc = jnp.cumsum(g, axis=-1)
    idx = jnp.arange(DN_CHUNK)
    incl = idx[:, None] >= idx[None, :]
    strict = idx[:, None] > idx[None, :]
    decay = jnp.exp(jnp.where(incl, gc[..., :, None] - gc[..., None, :], -jnp.inf))
    kb = k * beta[..., None]
    m = jnp.eye(DN_CHUNK, dtype=F32) + jnp.where(strict, jnp.einsum('bhnid,bhnjd->bhnij', kb, k) * decay, 0.0)
    rhs = jnp.concatenate([v * beta[..., None], kb * jnp.exp(gc)[..., None]], axis=-1)
    sol = lax.linalg.triangular_solve(m, rhs, left_side=True, lower=True, unit_diagonal=True)
    u, w = sol[..., :dv], sol[..., dv:]
    attn = jnp.einsum('bhnid,bhnjd->bhnij', q, k) * decay
    qg = q * jnp.exp(gc)[..., None]
    kg = k * jnp.exp(gc[..., -1:] - gc)[..., None]
    g_last = jnp.exp(gc[..., -1])

    def step(s, xs):
        u_n, w_n, a_n, q_n, k_n, gl_n = xs
        v_new = u_n - jnp.einsum('bhck,bhkv->bhcv', w_n, s)
        o_n = jnp.einsum('bhck,bhkv->bhcv', q_n, s) + jnp.einsum('bhij,bhjv->bhiv', a_n, v_new)
        s = s * gl_n[..., None, None] + jnp.einsum('bhck,bhcv->bhkv', k_n, v_new)
        return s, o_n

    xs = tuple(jnp.moveaxis(t, 2, 0) for t in (u, w, attn, qg, kg, g_last))
    s_t, o = lax.scan(step, s0, xs)
    return from_chunks(o), s_t


def deltanet_mixer(qkv_x, qkv_c, z_x, z_c, beta_x, beta_c, a_x, a_c, conv_w, a_log, dt_bias, norm_w, need_ctx):
    rows = qkv_x.shape[1] // GRID_W
    qkv_x = jax.nn.silu(depthwise_conv2d(qkv_x, conv_w, rows))
    qkv_c = jax.nn.silu(depthwise_conv1d(qkv_c, conv_w[DN_CONV // 2]))
    a_log = a_log.astype(F32)
    dt_bias = dt_bias.astype(F32)

    def prep(qkv, beta, a):
        b, n = qkv.shape[0], qkv.shape[1]
        q, k, v = [t.reshape(b, n, DN_HEADS, DN_HEAD_DIM) for t in jnp.split(qkv.astype(F32), 3, axis=-1)]
        q = l2_normalize(q) * DN_HEAD_DIM ** -0.5
        k = l2_normalize(k)
        beta = jax.nn.sigmoid(beta.astype(F32))
        a = a.astype(F32)
        dirs = []
        for d in range(2):
            hs = slice(d * DN_HEADS, (d + 1) * DN_HEADS)
            g = -jnp.exp(a_log[d]) * jax.nn.softplus(a[..., hs] + dt_bias[d])
            dirs.append((beta[..., hs], g))
        return (q, k, v), dirs

    shared_x, dirs_x = prep(qkv_x, beta_x, a_x)
    shared_c, dirs_c = prep(qkv_c, beta_c, a_c)
    s0 = jnp.zeros((qkv_x.shape[0], DN_HEADS, DN_HEAD_DIM, DN_HEAD_DIM), F32)
    o_x, o_c = run_bidirectional(gated_delta_rule, shared_x, shared_c, dirs_x, dirs_c, s0, need_ctx)

    def gate_out(o, z):
        b, n = z.shape[0], z.shape[1]
        y = rms_norm(o, norm_w) * jax.nn.silu(z.astype(F32).reshape(b, n, DN_HEADS, DN_HEAD_DIM))
        return y.reshape(b, n, DN_WIDTH).astype(z.dtype)

    return gate_out(o_x, z_x), (gate_out(o_c, z_c) if need_ctx else None)


def even_mixer(hx, hc, w_in, lam_re, lam_im, log_step, b_re, b_im, c_re, c_im, d_skip,
               conv_w, a_log, dt_bias, norm_w, w_out, need_ctx):
    cuts = _cuts(EVEN_COLS)
    qkv_x, z_x, u_x, g_x, beta_x, a_x = jnp.split(hx @ w_in, cuts, axis=-1)
    qkv_c, z_c, u_c, g_c, beta_c, a_c = jnp.split(hc @ w_in, cuts, axis=-1)
    s5_x, s5_c = s5_mixer(u_x, u_c, g_x, g_c, lam_re, lam_im, log_step, b_re, b_im, c_re, c_im, d_skip, need_ctx)
    dn_x, dn_c = deltanet_mixer(qkv_x, qkv_c, z_x, z_c, beta_x, beta_c, a_x, a_c,
                                conv_w, a_log, dt_bias, norm_w, need_ctx)
    y_x = jnp.concatenate([s5_x, dn_x], axis=-1) @ w_out
    y_c = jnp.concatenate([s5_c, dn_c], axis=-1) @ w_out if need_ctx else None
    return y_x, y_c


def gla_rule(q, k, v, glog, s0):
    q, k, v, glog = (to_chunks(t, GLA_CHUNK) for t in (q, k, v, glog))
    cum = jnp.cumsum(glog, axis=3)
    q_in = q * jnp.exp(cum)
    k_in = k * jnp.exp(-cum)
    idx = jnp.arange(GLA_CHUNK)
    incl = idx[:, None] >= idx[None, :]
    attn = jnp.where(incl, jnp.einsum('bhnik,bhnjk->bhnij', q_in, k_in), 0.0)
    k_dec = k * jnp.exp(cum[..., -1:, :] - cum)
    g_last = jnp.exp(cum[..., -1, :])

    def step(s, xs):
        q_n, k_n, v_n, a_n, g_n = xs
        o_n = jnp.einsum('bhck,bhkv->bhcv', q_n, s) + jnp.einsum('bhij,bhjv->bhiv', a_n, v_n)
        s = s * g_n[..., None] + jnp.einsum('bhck,bhcv->bhkv', k_n, v_n)
        return s, o_n

    xs = tuple(jnp.moveaxis(t, 2, 0) for t in (q_in, k_dec, v, attn, g_last))
    s_t, o = lax.scan(step, s0, xs)
    return from_chunks(o), s_t


def odd_mixer(hx, hc, w_in, gate_w2, gate_b, norm_w, w_out, need_ctx):
    cuts = _cuts(ODD_COLS)
    gate_w2 = gate_w2.astype(F32)
    gate_b = gate_b.astype(F32)

    def prep(p):
        b, n = p.shape[0], p.shape[1]
        q, k, v, r, lr = jnp.split(p.astype(F32), cuts, axis=-1)
        q = q.reshape(b, n, GLA_HEADS, GLA_DK) * GLA_DK ** -0.5
        k = k.reshape(b, n, GLA_HEADS, GLA_DK)
        v = v.reshape(b, n, GLA_HEADS, GLA_DV)
        dirs = []
        for d in range(2):
            z = lr[..., d * GLA_RANK:(d + 1) * GLA_RANK] @ gate_w2[d] + gate_b[d]
            dirs.append((jax.nn.log_sigmoid(z).reshape(b, n, GLA_HEADS, GLA_DK) / GLA_TAU,))
        return (q, k, v), dirs, r

    shared_x, dirs_x, r_x = prep(hx @ w_in)
    shared_c, dirs_c, r_c = prep(hc @ w_in)
    s0 = jnp.zeros((hx.shape[0], GLA_HEADS, GLA_DK, GLA_DV), F32)
    o_x, o_c = run_bidirectional(gla_rule, shared_x, shared_c, dirs_x, dirs_c, s0, need_ctx)

    def gate_out(o, r):
        b, n = r.shape[0], r.shape[1]
        y = rms_norm(o, norm_w) * jax.nn.silu(r.reshape(b, n, GLA_HEADS, GLA_DV))
        return y.reshape(b, n, GLA_VAL_WIDTH).astype(hx.dtype) @ w_out

    return gate_out(o_x, r_x), (gate_out(o_c, r_c) if need_ctx else None)


def moe_swiglu(h, w_router, w1, w3, w2):
    n_tok, d_model = h.shape
    n_asg = n_tok * TOP_K
    logits = (h @ w_router).astype(F32)
    top_logit, top_e = lax.top_k(logits, TOP_K)
    gate = jax.nn.softmax(top_logit, axis=-1).astype(h.dtype).reshape(n_asg)
    flat_e = top_e.reshape(n_asg).astype(jnp.int32)
    flat_tok = jnp.repeat(jnp.arange(n_tok, dtype=jnp.int32), TOP_K)
    order = jnp.argsort(flat_e)
    sorted_e, sorted_tok, sorted_gate = flat_e[order], flat_tok[order], gate[order]
    counts = jnp.zeros((N_EXPERTS,), jnp.int32).at[flat_e].add(1)
    padded = (counts + MOE_BLOCK - 1) // MOE_BLOCK * MOE_BLOCK
    start = jnp.cumsum(counts) - counts
    padded_end = jnp.cumsum(padded)
    padded_start = padded_end - padded
    dest = padded_start[sorted_e] + jnp.arange(n_asg, dtype=jnp.int32) - start[sorted_e]
    n_blocks = -(-n_asg // MOE_BLOCK) + N_EXPERTS
    n_rows = n_blocks * MOE_BLOCK
    row_tok = jnp.zeros((n_rows,), jnp.int32).at[dest].set(sorted_tok)
    xb = h[row_tok].reshape(n_blocks, MOE_BLOCK, d_model)
    block_e = jnp.minimum(jnp.searchsorted(padded_end, jnp.arange(n_blocks, dtype=jnp.int32) * MOE_BLOCK,
                                           side='right'), N_EXPERTS - 1)

    def expert_block(args):
        xblk, e = args
        return swiglu(xblk, w1[e], w3[e], w2[e])

    yb = lax.map(expert_block, (xb, block_e)).reshape(n_rows, d_model)
    return jnp.zeros_like(h).at[sorted_tok].add(yb[dest] * sorted_gate[:, None])


def setup_inputs(seed: int = 0):
    key = jax.random.key(seed)
    keys = iter(jax.random.split(key, 40))

    def normal(shape, scale):
        return jax.random.normal(next(keys), shape, F32) * scale

    def uniform(shape, lo, hi):
        return jax.random.uniform(next(keys), shape, F32, lo, hi)

    D = D_MODEL
    s5_shape = (N_EVEN, 2, S5_GROUPS, S5_STATE)
    dn_dt = jnp.exp(uniform((N_EVEN, 2, DN_HEADS), math.log(DN_DT_MIN), math.log(DN_DT_MAX)))
    return {
        'x': normal((BATCH, SEQ, D), 1.0),
        'c': normal((BATCH, D), 1.0),
        'ctx': normal((BATCH, CTX_LEN, D), 1.0),
        'c_ctx': normal((D,), 1.0),
        'ada_w': normal((DEPTH, D, N_MOD * D), 0.5 * D ** -0.5),
        'ada_b': normal((DEPTH, N_MOD * D), 0.02),
        'ln1_g': 1.0 + normal((DEPTH, D), 0.02),
        'ln1_b': normal((DEPTH, D), 0.02),
        'ln2_g': 1.0 + normal((DEPTH, D), 0.02),
        'ln2_b': normal((DEPTH, D), 0.02),
        'e_w_in': normal((N_EVEN, D, EVEN_IN), D ** -0.5),
        's5_lam_re': -0.5 + normal(s5_shape, 0.01),
        's5_lam_im': jnp.pi * jnp.arange(S5_STATE, dtype=F32) + normal(s5_shape, 0.01),
        's5_log_step': uniform((N_EVEN, 2, S5_GROUPS), math.log(S5_DT_MIN), math.log(S5_DT_MAX)),
        's5_b_re': normal((N_EVEN, 2, S5_GROUPS, S5_STATE, S5_GROUP), (2 * S5_GROUP) ** -0.5),
        's5_b_im': normal((N_EVEN, 2, S5_GROUPS, S5_STATE, S5_GROUP), (2 * S5_GROUP) ** -0.5),
        's5_c_re': normal((N_EVEN, 2, S5_GROUPS, S5_GROUP, S5_STATE), 0.5),
        's5_c_im': normal((N_EVEN, 2, S5_GROUPS, S5_GROUP, S5_STATE), 0.5),
        's5_d': normal((N_EVEN, S5_WIDTH), 0.5),
        'dn_conv': normal((N_EVEN, DN_CONV, DN_CONV, 3 * DN_WIDTH), 1.0 / DN_CONV),
        'dn_a_log': jnp.log(uniform((N_EVEN, 2, DN_HEADS), 1.0, 16.0)),
        'dn_dt_bias': dn_dt + jnp.log(-jnp.expm1(-dn_dt)),
        'dn_norm_w': 1.0 + normal((N_EVEN, DN_HEAD_DIM), 0.02),
        'e_w_out': normal((N_EVEN, EVEN_MIX, D), DEEPNORM_BETA * EVEN_MIX ** -0.5),
        'ffn_w1': normal((N_EVEN, D, FFN_HIDDEN), D ** -0.5),
        'ffn_w3': normal((N_EVEN, D, FFN_HIDDEN), D ** -0.5),
        'ffn_w2': normal((N_EVEN, FFN_HIDDEN, D), DEEPNORM_BETA * FFN_HIDDEN ** -0.5),
        'o_w_in': normal((N_ODD, D, ODD_IN), D ** -0.5),
        'gla_w2': normal((N_ODD, 2, GLA_RANK, GLA_KEY_WIDTH), GLA_RANK ** -0.5),
        'gla_b': normal((N_ODD, 2, GLA_KEY_WIDTH), 0.1),
        'gla_norm_w': 1.0 + normal((N_ODD, GLA_DV), 0.02),
        'o_w_out': normal((N_ODD, GLA_VAL_WIDTH, D), DEEPNORM_BETA * GLA_VAL_WIDTH ** -0.5),
        'moe_router': normal((N_ODD, D, N_EXPERTS), D ** -0.5),
        'moe_w1': normal((N_ODD, N_EXPERTS, D, EXPERT_HIDDEN), D ** -0.5),
        'moe_w3': normal((N_ODD, N_EXPERTS, D, EXPERT_HIDDEN), D ** -0.5),
        'moe_w2': normal((N_ODD, N_EXPERTS, EXPERT_HIDDEN, D), DEEPNORM_BETA * EXPERT_HIDDEN ** -0.5),
    }


def reference(x, c, ctx, c_ctx, ada_w, ada_b, ln1_g, ln1_b, ln2_g, ln2_b,
              e_w_in, s5_lam_re, s5_lam_im, s5_log_step, s5_b_re, s5_b_im,
              s5_c_re, s5_c_im, s5_d, dn_conv, dn_a_log, dn_dt_bias, dn_norm_w,
              e_w_out, ffn_w1, ffn_w3, ffn_w2, o_w_in, gla_w2, gla_b, gla_norm_w,
              o_w_out, moe_router, moe_w1, moe_w3, moe_w2):
    n_lat = x.shape[0] * x.shape[1]
    for i in range(DEPTH):
        j = i // 2
        need_ctx = i < DEPTH - 1
        sh1, sc1, gt1, sh2, sc2, gt2 = [m[:, None, :] for m in adaln(c, ada_w[i], ada_b[i])]
        csh1, csc1, cgt1, csh2, csc2, cgt2 = adaln(c_ctx, ada_w[i], ada_b[i])
        hx = modulate(x, sh1, sc1)
        hc = modulate(ctx, csh1, csc1)
        if i % 2 == 0:
            mix_x, mix_c = even_mixer(hx, hc, e_w_in[j], s5_lam_re[j], s5_lam_im[j], s5_log_step[j],
                                      s5_b_re[j], s5_b_im[j], s5_c_re[j], s5_c_im[j], s5_d[j],
                                      dn_conv[j], dn_a_log[j], dn_dt_bias[j], dn_norm_w[j], e_w_out[j], need_ctx)
        else:
            mix_x, mix_c = odd_mixer(hx, hc, o_w_in[j], gla_w2[j], gla_b[j], gla_norm_w[j], o_w_out[j], need_ctx)
        x = layer_norm(DEEPNORM_ALPHA * x + gt1 * mix_x, ln1_g[i], ln1_b[i])
        tokens = [modulate(x, sh2, sc2).reshape(n_lat, D_MODEL)]
        if need_ctx:
            ctx = layer_norm(DEEPNORM_ALPHA * ctx + cgt1 * mix_c, ln1_g[i], ln1_b[i])
            tokens.append(modulate(ctx, csh2, csc2).reshape(-1, D_MODEL))
        tokens = jnp.concatenate(tokens, axis=0)
        if i % 2 == 0:
            f = swiglu(tokens, ffn_w1[j], ffn_w3[j], ffn_w2[j])
        else:
            f = moe_swiglu(tokens, moe_router[j], moe_w1[j], moe_w3[j], moe_w2[j])
        x = layer_norm(DEEPNORM_ALPHA * x + gt2 * f[:n_lat].reshape(x.shape), ln2_g[i], ln2_b[i])
        if need_ctx:
            ctx = layer_norm(DEEPNORM_ALPHA * ctx + cgt2 * f[n_lat:].reshape(ctx.shape), ln2_g[i], ln2_b[i])
    return x
```

```cpp
#include <hip/hip_runtime.h>
#include <cstdio>
#include <cstdint>

#ifndef MK_LAUNCHES
#define MK_LAUNCHES 1
#endif

#define LAS __attribute__((address_space(3)))
typedef unsigned short bf16_t;
typedef short bf16x8 __attribute__((ext_vector_type(8)));
typedef float f32x4 __attribute__((ext_vector_type(4)));
typedef float f32x2 __attribute__((ext_vector_type(2)));
typedef unsigned u32x4 __attribute__((ext_vector_type(4)));
typedef unsigned u32x2 __attribute__((ext_vector_type(2)));

constexpr int D = 2048, NB = 4, SEQ = 4096, CTXL = 256;
constexpr int NL = NB * SEQ;
constexpr int NC = NB * CTXL;
constexpr int MT = NL + NC;
constexpr int EIN = 6176, EINP = 6400;
constexpr int FFH = 5632, EXH = 7168, NEXP = 8;
constexpr float ALPHA = 1.41421356237f;
constexpr float EPS = 1e-6f;
constexpr int NMOD = 12288;
constexpr int S5ROWS = 1280, S5CH = 272;
constexpr int NCH = 68;
constexpr size_t DN_STRIDE = 73984, DN_W = 0, DN_QG = 16384, DN_KGT = 32768, DN_UT = 49152, DN_ATT = 65536, DN_GL = 73728;
constexpr size_t GL_STRIDE = 74752, GL_QIN = 0, GL_KDT = 32768, GL_ATT = 65536, GL_GL = 73728;
constexpr size_t GLV_STRIDE = 65536;
constexpr int MOE_MAXP = 136;

constexpr size_t MiB = 1u << 20;
constexpr size_t WS_CTL = 0, CTL_ZERO_BYTES = 1 * MiB;
constexpr size_t WS_MOD = 1 * MiB;
constexpr size_t WS_MOE = 2 * MiB;
constexpr size_t MOE_TOPK = WS_MOE, MOE_DEST = WS_MOE + 16384 * 16, MOE_HIST = MOE_DEST + 16384 * 8, MOE_TBL = MOE_HIST + 256 * 8 * 4, MOE_RT = MOE_TBL + 1024, MOE_STATS = MOE_RT + 8 * 2048 * 4;
constexpr size_t WS_S5W = 4 * MiB;
constexpr size_t WS_S5M = 12 * MiB;
constexpr size_t WS_WIN1 = 28 * MiB;
constexpr size_t WS_WOUT1 = 53 * MiB;
constexpr size_t WS_W13M = 61 * MiB;
constexpr size_t WS_W2M = 509 * MiB;
constexpr size_t WS_WIN0 = 733 * MiB;
constexpr size_t WS_WOUT0 = 758 * MiB;
constexpr size_t WS_W130 = 766 * MiB;
constexpr size_t WS_W20 = 810 * MiB;
constexpr size_t DYN = 832 * MiB;
constexpr size_t WS_XR = DYN;
constexpr size_t WS_P = DYN + 136 * MiB;
constexpr size_t WS_A1 = DYN + 349 * MiB;
constexpr size_t WS_AS5 = DYN + 417 * MiB;
constexpr size_t WS_E = DYN + 497 * MiB;
constexpr size_t WS_A0 = DYN + 577 * MiB;
constexpr size_t WS_QKVN = DYN + 645 * MiB;
constexpr size_t WS_DNB = DYN + 747 * MiB;
constexpr size_t WS_ODN = DYN + 497 * MiB;
constexpr size_t WS_H0 = DYN + 645 * MiB;
constexpr size_t WS_GLB = DYN + 645 * MiB;
constexpr size_t WS_GLV = DYN + 801 * MiB;
constexpr size_t WS_OGL = DYN + 349 * MiB;
constexpr size_t WS_A1B = DYN + 477 * MiB;
constexpr size_t WS_A2B = DYN + 541 * MiB;
constexpr size_t WS_XG = DYN + 136 * MiB;
constexpr size_t WS_HM = DYN + 272 * MiB;
constexpr size_t WS_YG = DYN + 748 * MiB;
constexpr size_t WS_END = DYN + 1056 * MiB;
static_assert(WS_DNB + 4352 * DN_STRIDE <= WS_END, "ws");
static_assert(WS_GLB + 2176 * GL_STRIDE <= WS_GLV && WS_GLV + 1088 * GLV_STRIDE <= WS_END, "ws");
static_assert(WS_YG + (size_t)34816 * 2048 * 4 <= WS_END, "ws");
static_assert(WS_HM + (size_t)34816 * 7168 * 2 <= WS_YG, "ws");
static_assert(WS_H0 + (size_t)MT * FFH * 2 <= WS_END, "ws");
static_assert(WS_ODN + (size_t)2 * MT * 1024 * 4 <= WS_QKVN, "ws");
static_assert(MOE_STATS + 17408 * 8 <= WS_S5W, "ws");
constexpr int CW_BAR = 4096;

constexpr int RING_BYTES = 131072;
constexpr int MISC_OFF = 147456 - 256;
constexpr int LDS_BYTES = 147456;

__device__ __forceinline__ unsigned f2bf(float f) { unsigned u = __builtin_bit_cast(unsigned, f); return (u + 0x7fffu + ((u >> 16) & 1u)) >> 16; }
typedef __bf16 bf16x2_t __attribute__((ext_vector_type(2)));
__device__ __forceinline__ unsigned pk2(float lo, float hi) { const f32x2 v = {lo, hi}; const bf16x2_t b = __builtin_convertvector(v, bf16x2_t); return __builtin_bit_cast(unsigned, b); }
__device__ __forceinline__ float bflo(unsigned u) { return __builtin_bit_cast(float, u << 16); }
__device__ __forceinline__ float bfhi(unsigned u) { return __builtin_bit_cast(float, u & 0xffff0000u); }
__device__ __forceinline__ float bf1(bf16_t b) { return __builtin_bit_cast(float, (unsigned)b << 16); }
__device__ __forceinline__ float wave_sum(float v) {
#pragma unroll
    for (int o = 1; o < 64; o <<= 1) v += __shfl_xor(v, o);
    return v;
}
__device__ __forceinline__ float sigmoidf_(float x) { return __builtin_amdgcn_rcpf(1.0f + __expf(-x)); }
__device__ __forceinline__ float siluf_(float x) { return x * __builtin_amdgcn_rcpf(1.0f + __expf(-x)); }
__device__ __forceinline__ float gelu_tanh(float x) { const float u = 0.7978845608f * (x + 0.044715f * x * x * x); const float e = __expf(2.0f * u); const float t = 1.0f - 2.0f * __builtin_amdgcn_rcpf(e + 1.0f); return 0.5f * x * (1.0f + t); }
__device__ __forceinline__ float softplusf_(float x) { return x > 20.f ? x : log1pf(__expf(x)); }
#define LDS_WAIT() asm volatile("s_waitcnt lgkmcnt(0)" ::: "memory")

#define XB_TMO      128
#define XB_XCNT(j)  (256  + 64 * (j))
#define XB_XSUB(j)  (1280 + 64 * (j))
#define XB_XGEN(j)  (2304 + 64 * (j))
#define XB_TOP      3328
#define XB_TOPGEN   3392
#define XCD_BAR_WORDS 3456
#define XB_SPIN_CAP (1u << 18)
__device__ __forceinline__ unsigned xb_ld(unsigned* p)              { return __hip_atomic_load(p, __ATOMIC_RELAXED, __HIP_MEMORY_SCOPE_AGENT); }
__device__ __forceinline__ unsigned xb_add(unsigned* p, unsigned v) { return __hip_atomic_fetch_add(p, v, __ATOMIC_RELAXED, __HIP_MEMORY_SCOPE_AGENT); }
__device__ __forceinline__ unsigned xb_xcc_id() { return (unsigned)__builtin_amdgcn_s_getreg((3 << 11) | 20) & 0xFu; }
#define XB_SPIN(cond, bar) do { unsigned _sp = 0; while (cond) { __builtin_amdgcn_s_sleep(1); \
    if ((++_sp & 255u) == 0u) { if (xb_ld(&(bar)[XB_TMO])) break; if (_sp > XB_SPIN_CAP) { atomicAdd(&(bar)[XB_TMO], 1u); break; } } } } while (0)
struct XcdBarrier { unsigned* bar; unsigned x; volatile LAS unsigned* st; };
__device__ __forceinline__ XcdBarrier xcd_barrier_post(unsigned* bar, volatile LAS unsigned* st) {
    XcdBarrier b; b.bar = bar; b.x = xb_xcc_id(); b.st = st;
    if (threadIdx.x == 0) (void)xb_add(&bar[XB_XCNT(b.x)], 1u);
    return b;
}
__device__ __forceinline__ void xcd_barrier_complete(unsigned* bar, unsigned x, unsigned& nloc, unsigned& nx) {
    const unsigned G = gridDim.x * gridDim.y * gridDim.z;
    unsigned sum, cnt, mine, sp = 0u;
    for (;;) {
        sum = 0u; cnt = 0u; mine = 0u;
#pragma unroll
        for (unsigned j = 0; j < 16; ++j) { const unsigned c = xb_ld(&bar[XB_XCNT(j)]); sum += c; cnt += (c > 0u) ? 1u : 0u; mine = (j == x) ? c : mine; }
        if (sum == G) break;
        __builtin_amdgcn_s_sleep(1);
        if ((++sp & 255u) == 0u) { if (xb_ld(&bar[XB_TMO])) break; if (sp > XB_SPIN_CAP) { atomicAdd(&bar[XB_TMO], 1u); break; } }
    }
    nloc = mine > 0u ? mine : 1u; nx = cnt > 0u ? cnt : 1u;
}
__device__ __forceinline__ void xcd_barrier(const XcdBarrier& b) {
    asm volatile("s_waitcnt vmcnt(0)" ::: "memory");
    __syncthreads();
    if (threadIdx.x == 0) {
        unsigned* bar = b.bar;
        __builtin_amdgcn_s_waitcnt(0);
        unsigned nloc = b.st[0], nx = b.st[1];
        if (nloc == 0u) { xcd_barrier_complete(bar, b.x, nloc, nx); b.st[0] = nloc; b.st[1] = nx; }
        const unsigned old = xb_add(&bar[XB_XSUB(b.x)], 1u);
        const unsigned gen = old / nloc;
        if (old + 1u == (gen + 1u) * nloc) {
            __builtin_amdgcn_fence(__ATOMIC_RELEASE, "agent");
            asm volatile("s_waitcnt vmcnt(0)" ::: "memory");
            const unsigned og = xb_add(&bar[XB_TOP], 1u);
            const unsigned tg = og / nx;
            if (og + 1u == (tg + 1u) * nx) xb_add(&bar[XB_TOPGEN], 1u);
            else XB_SPIN(xb_ld(&bar[XB_TOPGEN]) == tg, bar);
            __builtin_amdgcn_fence(__ATOMIC_ACQUIRE, "agent");
            xb_add(&bar[XB_XGEN(b.x)], 1u);
            asm volatile("s_waitcnt vmcnt(0)" ::: "memory");
        } else {
            XB_SPIN(xb_ld(&bar[XB_XGEN(b.x)]) == gen, bar);
            __builtin_amdgcn_fence(__ATOMIC_ACQUIRE, "agent");
            asm volatile("s_waitcnt vmcnt(0)" ::: "memory");
        }
    }
    __syncthreads();
}

namespace pg8 {
constexpr int BM = 256, BK = 64, HALF = 128, HTB = HALF * BK * 2, STAGE_BYTES = 8 * HTB, NXCD = 8, WGM = 8;
__host__ __device__ __forceinline__ int lds_byte(int r, int c) { const int st = (r >> 4) * 2 + (c >> 5), rr = r & 15, cc = c & 31, ob = rr * 64 + cc * 2; return st * 1024 + (ob ^ (((ob >> 9) & 1) << 5)); }
__host__ __device__ __forceinline__ void stage_rc(int b, int& R, int& C) { const int st = b / 1024, sb = b % 1024, swz = sb ^ (((sb >> 9) & 1) << 5); R = (st >> 1) * 16 + swz / 64; C = (st & 1) * 32 + (swz % 64) / 2; }
__host__ __device__ __forceinline__ int perm32(int rho) { const int n = rho >> 4, i = rho & 15; return 8 * (i >> 2) + 4 * n + (i & 3); }

struct Unit { int pm, pn; const char* a; const char* b; };
struct Gemm { int lda, ldb, K; };

struct SchedDense {
    const char* A; const char* B; size_t a_t, b_t; int nM, nN, nwg, G, c;
    __device__ void init(const void* A_, const void* B_, int lda, int ldb, int nM_, int nN_, int G_, int c_) { A = (const char*)A_; B = (const char*)B_; a_t = (size_t)BM * lda * 2; b_t = (size_t)BM * ldb * 2; nM = nM_; nN = nN_; nwg = nM * nN; G = G_; c = c_; }
    __device__ bool next(int i, Unit& u) const {
        const long L = (long)i * G + c; if (L >= nwg) return false;
        int wgid = (int)L; { const int q = nwg / NXCD, r = nwg % NXCD, xcd = wgid % NXCD, off = wgid / NXCD; wgid = (xcd < r ? xcd * (q + 1) : r * (q + 1) + (xcd - r) * q) + off; }
        const int nig = WGM * nN, gid = wgid / nig, fm = gid * WGM, gsz = (nM - fm) < WGM ? (nM - fm) : WGM;
        u.pm = fm + ((wgid % nig) % gsz); u.pn = (wgid % nig) / gsz; u.a = A + (size_t)u.pm * a_t; u.b = B + (size_t)u.pn * b_t; return true;
    }
};
struct SchedGroup {
    const char* A; const char* B; size_t a_t, b_t, b_e; const int* tbl; int div, nP, nN, nwg, G, c;
    __device__ void init(const void* A_, const void* B_, int lda, int ldb, size_t b_e_, const int* tbl_, int div_, int nP_, int nN_, int G_, int c_) { A = (const char*)A_; B = (const char*)B_; a_t = (size_t)BM * lda * 2; b_t = (size_t)BM * ldb * 2; b_e = b_e_; tbl = tbl_; div = div_; nP = nP_; nN = nN_; nwg = nP * nN; G = G_; c = c_; }
    __device__ bool next(int i, Unit& u) const {
        const long L = (long)i * G + c; if (L >= nwg) return false;
        int wgid = (int)L; { const int q = nwg / NXCD, r = nwg % NXCD, xcd = wgid % NXCD, off = wgid / NXCD; wgid = (xcd < r ? xcd * (q + 1) : r * (q + 1) + (xcd - r) * q) + off; }
        const int nig = WGM * nN, gid = wgid / nig, fm = gid * WGM, gsz = (nP - fm) < WGM ? (nP - fm) : WGM;
        u.pm = fm + ((wgid % nig) % gsz); u.pn = (wgid % nig) / gsz; const int e = tbl ? tbl[u.pm] : u.pm / div;
        u.a = A + (size_t)u.pm * a_t; u.b = B + (size_t)e * b_e + (size_t)u.pn * b_t; return true;
    }
};

struct SchedSplit {
    const char* A; const char* B; size_t a_t, b_t, b_e, ksb; const int* tbl; int pm0, nN, S, nsub, G, c;
    __device__ void init(const void* A_, const void* B_, int lda, int ldb, size_t b_e_, const int* tbl_, int pm0_, int nN_, int U, int S_, int Ksub, int G_, int c_) { A = (const char*)A_; B = (const char*)B_; a_t = (size_t)BM * lda * 2; b_t = (size_t)BM * ldb * 2; b_e = b_e_; ksb = (size_t)Ksub * 2; tbl = tbl_; pm0 = pm0_; nN = nN_; S = S_; nsub = U * S_; G = G_; c = c_; }
    __device__ bool next(int i, Unit& u) const {
        const long L = (long)i * G + c; if (L >= nsub) return false;
        const int uu = (int)(L / S), sx = (int)(L % S), pm = pm0 + uu / nN, pn = uu % nN; const int e = tbl ? tbl[pm] : 0;
        u.pm = (int)L; u.pn = 0; u.a = A + (size_t)pm * a_t + sx * ksb; u.b = B + (size_t)e * b_e + (size_t)pn * b_t + sx * ksb; return true;
    }
};
template <class Epi, class Sched>
__device__ __forceinline__ void gemm_phase(LAS unsigned char* lds, const Gemm g, const Sched& S, const Epi& E) {
    const int tid = threadIdx.x, wid = __builtin_amdgcn_readfirstlane(tid >> 6), lane = tid & 63, wr = wid >> 2, wc = wid & 3, fr = lane & 15, fq = lane >> 4;
    const int K = g.K, nt = K / BK;
    unsigned voffA[2], voffB[2];
#pragma unroll
    for (int i = 0; i < 2; ++i) { int R, C; stage_rc(tid * 16 + i * 8192, R, C); const int Rb = Epi::PERM ? ((R & ~31) + perm32(R & 31)) : R;
        voffA[i] = (unsigned)(R * g.lda + C) * 2u; voffB[i] = (unsigned)(Rb * g.ldb + C) * 2u; }
    const size_t kstep = (size_t)(BK * 2);
    const size_t hA = (size_t)HALF * g.lda * 2, hB = (size_t)HALF * g.ldb * 2;
    const unsigned ldsw = (unsigned)wid * 1024u;
    const int aoff = lds_byte(wr * 64 + fr, fq * 8), boff = lds_byte(wc * 32 + fr, fq * 8);
#define PG8_SA(b, h) (((b) * 2 + (h)) * HTB)
#define PG8_SB(b, h) ((4 + (b) * 2 + (h)) * HTB)
#define PG8_STAGE(bufoff, gbase, voff) do { _Pragma("unroll") for (int _i = 0; _i < 2; ++_i) \
        __builtin_amdgcn_global_load_lds((const unsigned*)((const char*)(gbase) + (voff)[_i]), (LAS unsigned*)(lds + (bufoff) + ldsw + _i * 8192), 16, 0, 0); } while (0)
#define PG8_LDA(dst, b, h) do { _Pragma("unroll") for (int m = 0; m < 4; ++m) _Pragma("unroll") for (int k = 0; k < 2; ++k) dst[m][k] = *(const LAS bf16x8*)(lds + PG8_SA(b, h) + aoff + m * 2048 + k * 1024); } while (0)
#define PG8_LDB(dst, b, h) do { _Pragma("unroll") for (int n = 0; n < 2; ++n) _Pragma("unroll") for (int k = 0; k < 2; ++k) dst[n][k] = *(const LAS bf16x8*)(lds + PG8_SB(b, h) + boff + n * 2048 + k * 1024); } while (0)
#define PG8_MMA(ai, bj, At, Bt) do { __builtin_amdgcn_s_setprio(1); _Pragma("unroll") for (int m = 0; m < 4; ++m) _Pragma("unroll") for (int n = 0; n < 2; ++n) _Pragma("unroll") for (int k = 0; k < 2; ++k) \
        acc[ai][bj][m][n] = __builtin_amdgcn_mfma_f32_16x16x32_bf16(Bt[n][k], At[m][k], acc[ai][bj][m][n], 0, 0, 0); __builtin_amdgcn_s_setprio(0); } while (0)
#define PG8_WAIT_V(n) asm volatile("s_waitcnt vmcnt(" #n ")" ::: "memory")
#define PG8_WAIT_L(n) asm volatile("s_waitcnt lgkmcnt(" #n ")" ::: "memory")
#define PG8_BAR __builtin_amdgcn_s_barrier()
#define PG8_SCHED __builtin_amdgcn_sched_barrier(0)
    Unit cur, nxt; int ui = 0;
    if (!S.next(0, cur)) return;
    f32x4 acc[2][2][4][2];
#pragma unroll
    for (int a = 0; a < 2; ++a)
#pragma unroll
        for (int b = 0; b < 2; ++b)
#pragma unroll
            for (int m = 0; m < 4; ++m)
#pragma unroll
                for (int n = 0; n < 2; ++n) acc[a][b][m][n] = (f32x4){0.f, 0.f, 0.f, 0.f};
    bf16x8 At[4][2], B0[2][2], B1[2][2];
    const char* cA = cur.a; const char* cB = cur.b;
    PG8_STAGE(PG8_SB(0, 0), cB, voffB); PG8_STAGE(PG8_SB(0, 1), cB + hB, voffB); PG8_STAGE(PG8_SA(0, 0), cA, voffA); PG8_STAGE(PG8_SA(0, 1), cA + hA, voffA);
    if (wr == 1) PG8_BAR;
    PG8_WAIT_V(2); PG8_BAR;
    PG8_STAGE(PG8_SB(1, 0), cB + kstep, voffB); PG8_STAGE(PG8_SA(1, 0), cA + kstep, voffA); PG8_STAGE(PG8_SB(1, 1), cB + hB + kstep, voffB);
    PG8_WAIT_V(6); PG8_BAR;
    for (;;) {
        const bool has_next = S.next(ui + 1, nxt);
        const char* nA = has_next ? nxt.a : cA; const char* nB = has_next ? nxt.b : cB;
        for (int t = 0; t < nt; t += 2) {
            const bool last = (t == nt - 2);
            const char* a1 = cA + (size_t)(t + 1) * kstep;
            const char* a2 = last ? nA : cA + (size_t)(t + 2) * kstep; const char* b2 = last ? nB : cB + (size_t)(t + 2) * kstep;
            const char* a3 = a2 + kstep; const char* b3 = b2 + kstep;
            PG8_LDB(B0, 0, 0); PG8_LDB(B1, 0, 1); PG8_SCHED; PG8_LDA(At, 0, 0); PG8_STAGE(PG8_SA(1, 1), a1 + hA, voffA);
            PG8_WAIT_V(8); PG8_WAIT_L(0); PG8_BAR; PG8_MMA(0, 0, At, B0); PG8_MMA(0, 1, At, B1); PG8_BAR; PG8_SCHED;
            PG8_LDA(At, 0, 1); PG8_STAGE(PG8_SB(0, 0), b2, voffB); PG8_STAGE(PG8_SB(0, 1), b2 + hB, voffB); PG8_STAGE(PG8_SA(0, 0), a2, voffA);
            PG8_WAIT_V(8); PG8_WAIT_L(0); PG8_BAR; PG8_MMA(1, 0, At, B0); PG8_MMA(1, 1, At, B1); PG8_BAR; PG8_SCHED;
            PG8_LDB(B0, 1, 0); PG8_LDB(B1, 1, 1); PG8_SCHED; PG8_LDA(At, 1, 0); PG8_STAGE(PG8_SA(0, 1), a2 + hA, voffA);
            PG8_WAIT_V(8); PG8_WAIT_L(0); PG8_BAR; PG8_MMA(0, 0, At, B0); PG8_MMA(0, 1, At, B1); PG8_BAR; PG8_SCHED;
            PG8_LDA(At, 1, 1); PG8_STAGE(PG8_SB(1, 0), b3, voffB); PG8_STAGE(PG8_SB(1, 1), b3 + hB, voffB); PG8_STAGE(PG8_SA(1, 0), a3, voffA);
            PG8_WAIT_V(8); PG8_WAIT_L(0); PG8_BAR; PG8_MMA(1, 0, At, B0); PG8_MMA(1, 1, At, B1); PG8_BAR; PG8_SCHED;
        }
        if (wr == 0) PG8_BAR;
        E(acc, cur, wr, wc, fr, fq);
        if (!has_next) break;
#pragma unroll
        for (int a = 0; a < 2; ++a)
#pragma unroll
            for (int b = 0; b < 2; ++b)
#pragma unroll
                for (int m = 0; m < 4; ++m)
#pragma unroll
                    for (int n = 0; n < 2; ++n) acc[a][b][m][n] = (f32x4){0.f, 0.f, 0.f, 0.f};
        cur = nxt; cA = nA; cB = nB; ++ui;
        if (wr == 1) PG8_BAR;
    }
    PG8_WAIT_V(0);
    PG8_BAR;
#undef PG8_SA
#undef PG8_SB
#undef PG8_STAGE
#undef PG8_LDA
#undef PG8_LDB
#undef PG8_MMA
#undef PG8_WAIT_V
#undef PG8_WAIT_L
#undef PG8_BAR
#undef PG8_SCHED
}

struct EpiP0 {
    static constexpr bool PERM = true;
    bf16_t* P; bf16_t* As5;
    __device__ __forceinline__ void operator()(const f32x4 (&acc)[2][2][4][2], const Unit& u, int wr, int wc, int fr, int fq) const {
        const int row0 = u.pm * BM + wr * 64 + fr, col0 = u.pn * BM + wc * 32 + 8 * fq;
        const bool s5 = (u.pn >= 16 && u.pn < 20);
#pragma unroll
        for (int ai = 0; ai < 2; ++ai)
#pragma unroll
            for (int m = 0; m < 4; ++m) { const int r = row0 + ai * HALF + m * 16; bf16_t* rowp = P + (size_t)r * EINP + col0;
                int mrow, s;
                if (r < NL) { const int b = r >> 12, t = r & 4095; mrow = (16 + (t >> 4)) * 4 + b; s = t & 15; } else { const int rr = r - NL, b = rr >> 8, t = rr & 255; mrow = (t >> 4) * 4 + b; s = t & 15; }
#pragma unroll
                for (int bj = 0; bj < 2; ++bj) { const f32x4 v0 = acc[ai][bj][m][0], v1 = acc[ai][bj][m][1];
                    u32x4 w; w.x = pk2(v0[0], v0[1]); w.y = pk2(v0[2], v0[3]); w.z = pk2(v1[0], v1[1]); w.w = pk2(v1[2], v1[3]);
                    *(u32x4*)(rowp + bj * HALF) = w;
                    if (s5) { const int c0 = col0 + bj * HALF - 4096, gg = c0 >> 4, h0 = c0 & 15;
                        *(u32x4*)(As5 + ((size_t)(gg * S5ROWS + mrow) * 512 + s * 16 + h0)) = w; } } }
    }
};
struct EpiBf {
    static constexpr bool PERM = true;
    bf16_t* O; int ldc;
    __device__ __forceinline__ void operator()(const f32x4 (&acc)[2][2][4][2], const Unit& u, int wr, int wc, int fr, int fq) const {
        const int row0 = u.pm * BM + wr * 64 + fr, col0 = u.pn * BM + wc * 32 + 8 * fq;
#pragma unroll
        for (int ai = 0; ai < 2; ++ai)
#pragma unroll
            for (int m = 0; m < 4; ++m) { bf16_t* rowp = O + (size_t)(row0 + ai * HALF + m * 16) * ldc + col0;
#pragma unroll
                for (int bj = 0; bj < 2; ++bj) { const f32x4 v0 = acc[ai][bj][m][0], v1 = acc[ai][bj][m][1];
                    u32x4 w; w.x = pk2(v0[0], v0[1]); w.y = pk2(v0[2], v0[3]); w.z = pk2(v1[0], v1[1]); w.w = pk2(v1[2], v1[3]);
                    *(u32x4*)(rowp + bj * HALF) = w; } }
    }
};
struct EpiF32 {
    static constexpr bool PERM = false;
    float* C; int ldc;
    __device__ __forceinline__ void operator()(const f32x4 (&acc)[2][2][4][2], const Unit& u, int wr, int wc, int fr, int fq) const {
        const int row0 = u.pm * BM + wr * 64 + fr, col0 = u.pn * BM + wc * 32 + 4 * fq;
#pragma unroll
        for (int ai = 0; ai < 2; ++ai)
#pragma unroll
            for (int m = 0; m < 4; ++m) { float* rowp = C + (size_t)(row0 + ai * HALF + m * 16) * ldc + col0;
#pragma unroll
                for (int bj = 0; bj < 2; ++bj)
#pragma unroll
                    for (int n = 0; n < 2; ++n) *(f32x4*)(rowp + bj * HALF + n * 16) = acc[ai][bj][m][n]; }
    }
};
template <bool STATS>
struct EpiYT {
    static constexpr bool PERM = false;
    const float* resL; const float* resC; float* Y; const float* gate;
    const float* stats; const float* lg; const float* lb;
    __device__ __forceinline__ void operator()(const f32x4 (&acc)[2][2][4][2], const Unit& u, int wr, int wc, int fr, int fq) const {
        const int row0 = u.pm * BM + wr * 64 + fr, col0 = u.pn * BM + wc * 32 + 4 * fq;
        const int mb = u.pm < 64 ? (u.pm >> 4) : 4;
        const float* gp = gate + (size_t)mb * NMOD + col0;
        const float* rbase = (u.pm < 64 ? resL : resC - (size_t)NL * D) + (size_t)row0 * D + col0; float* ybase = Y + (size_t)row0 * D + col0;
        f32x2 st[2][4];
        if (STATS) {
#pragma unroll
            for (int ai = 0; ai < 2; ++ai)
#pragma unroll
                for (int m = 0; m < 4; ++m) st[ai][m] = *(const f32x2*)(stats + (size_t)(row0 + ai * HALF + m * 16) * 2); }
        f32x4 rv[2][2][4];
#pragma unroll
        for (int ai = 0; ai < 2; ++ai)
#pragma unroll
            for (int m = 0; m < 4; ++m) rv[0][ai][m] = *(const f32x4*)(rbase + (size_t)(ai * HALF + m * 16) * D);
#pragma unroll
        for (int g = 0; g < 4; ++g) { const int bj = g >> 1, n = g & 1; const int co = bj * HALF + n * 16; const f32x4 gv = *(const f32x4*)(gp + co);
            f32x4 gg = {1.f, 1.f, 1.f, 1.f}, bb = {0.f, 0.f, 0.f, 0.f}; if (STATS) { gg = *(const f32x4*)(lg + col0 + co); bb = *(const f32x4*)(lb + col0 + co); }
            if (g < 3) { const int co1 = ((g + 1) >> 1) * HALF + ((g + 1) & 1) * 16;
#pragma unroll
                for (int ai = 0; ai < 2; ++ai)
#pragma unroll
                    for (int m = 0; m < 4; ++m) rv[(g + 1) & 1][ai][m] = *(const f32x4*)(rbase + (size_t)(ai * HALF + m * 16) * D + co1); }
#pragma unroll
            for (int ai = 0; ai < 2; ++ai)
#pragma unroll
                for (int m = 0; m < 4; ++m) { f32x4 r = rv[g & 1][ai][m]; if (STATS) r = (r - st[ai][m].x) * st[ai][m].y * gg + bb;
                    *(f32x4*)(ybase + (size_t)(ai * HALF + m * 16) * D + co) = r * ALPHA + gv * acc[ai][bj][m][n]; } }
    }
};
struct EpiH {
    static constexpr bool PERM = true;
    bf16_t* H; int ldc;
    __device__ __forceinline__ void operator()(const f32x4 (&acc)[2][2][4][2], const Unit& u, int wr, int wc, int fr, int fq) const {
        const int row0 = u.pm * BM + wr * 64 + fr, col0 = u.pn * HALF + wc * 32 + 8 * fq;
#pragma unroll
        for (int ai = 0; ai < 2; ++ai)
#pragma unroll
            for (int m = 0; m < 4; ++m) { bf16_t* rowp = H + (size_t)(row0 + ai * HALF + m * 16) * ldc + col0;
                const f32x4 g0 = acc[ai][0][m][0], g1 = acc[ai][0][m][1], u0 = acc[ai][1][m][0], u1 = acc[ai][1][m][1];
                float o[8];
#pragma unroll
                for (int j = 0; j < 4; ++j) { o[j] = siluf_(g0[j]) * u0[j]; o[4 + j] = siluf_(g1[j]) * u1[j]; }
                u32x4 w; w.x = pk2(o[0], o[1]); w.y = pk2(o[2], o[3]); w.z = pk2(o[4], o[5]); w.w = pk2(o[6], o[7]);
                *(u32x4*)rowp = w; }
    }
};
struct EpiS5C {
    static constexpr bool PERM = true;
    const bf16_t* P; bf16_t* A1; const float* dskip;
    __device__ __forceinline__ void operator()(const f32x4 (&acc)[2][2][4][2], const Unit& u, int wr, int wc, int fr, int fq) const {
        const int gg = u.pm / 5, panel = u.pm % 5;
#pragma unroll
        for (int ai = 0; ai < 2; ++ai)
#pragma unroll
            for (int m = 0; m < 4; ++m) { const int mrow = panel * BM + ai * HALF + wr * 64 + m * 16 + fr;
                if (mrow < NB * S5CH) { const int b = mrow & 3, chunk = mrow >> 2;
#pragma unroll
                    for (int bj = 0; bj < 2; ++bj) { const int n0 = bj * HALF + wc * 32 + 8 * fq, t = n0 >> 4, h0 = n0 & 15;
                        const int r = chunk < 16 ? NL + b * CTXL + chunk * 16 + t : b * SEQ + (chunk - 16) * 16 + t;
                        const int ch = gg * 16 + h0;
                        const u32x4 uv = *(const u32x4*)(P + (size_t)r * EINP + 4096 + ch), gv = *(const u32x4*)(P + (size_t)r * EINP + 5120 + ch);
                        const f32x4 d0 = *(const f32x4*)(dskip + ch), d1 = *(const f32x4*)(dskip + ch + 4);
                        const f32x4 v0 = acc[ai][bj][m][0], v1 = acc[ai][bj][m][1];
                        float y[8], uu[8], gt[8];
                        uu[0] = bflo(uv.x); uu[1] = bfhi(uv.x); uu[2] = bflo(uv.y); uu[3] = bfhi(uv.y); uu[4] = bflo(uv.z); uu[5] = bfhi(uv.z); uu[6] = bflo(uv.w); uu[7] = bfhi(uv.w);
                        gt[0] = bflo(gv.x); gt[1] = bfhi(gv.x); gt[2] = bflo(gv.y); gt[3] = bfhi(gv.y); gt[4] = bflo(gv.z); gt[5] = bfhi(gv.z); gt[6] = bflo(gv.w); gt[7] = bfhi(gv.w);
#pragma unroll
                        for (int j = 0; j < 4; ++j) { y[j] = v0[j] + d0[j] * uu[j]; y[4 + j] = v1[j] + d1[j] * uu[4 + j]; }
#pragma unroll
                        for (int j = 0; j < 8; ++j) y[j] = gelu_tanh(y[j]) * sigmoidf_(gt[j]);
                        u32x4 w; w.x = pk2(y[0], y[1]); w.y = pk2(y[2], y[3]); w.z = pk2(y[4], y[5]); w.w = pk2(y[6], y[7]);
                        *(u32x4*)(A1 + (size_t)r * D + ch) = w; } } }
    }
};
}

constexpr int NWAVES = 8;
struct Args { const float* in[36]; float* out; unsigned char* ws; int ph_lo, ph_hi; };
struct Frame {
    LAS unsigned char* lds; unsigned char* ldsg;
    int tid, lane, wave, G, bid;
    const Args* ap; float* out; unsigned char* ws;
};
enum { I_X = 0, I_C, I_CTX, I_CCTX, I_ADAW, I_ADAB, I_LN1G, I_LN1B, I_LN2G, I_LN2B, I_EWIN, I_LAMRE, I_LAMIM, I_LOGSTEP, I_BRE, I_BIM, I_CRE, I_CIM, I_S5D, I_DNCONV, I_DNALOG, I_DNDT, I_DNNORM,
       I_EWOUT, I_FW1, I_FW3, I_FW2, I_OWIN, I_GLAW2, I_GLAB, I_GLANORM, I_OWOUT, I_ROUTER, I_MW1, I_MW3, I_MW2 };

__device__ __forceinline__ int tok_row(int b, int d, int n, int i) {
    if (n < 4) { const int t = 64 * n + i; return NL + b * CTXL + (d ? 255 - t : t); }
    const int t = 64 * (n - 4) + i; return b * SEQ + (d ? 4095 - t : t);
}

__device__ __forceinline__ void p0_transpose_item(const float* W, int K, int N, bf16_t* WT, int kb, int n0, int drow0, float* scr, int lane) {
    const int k0 = 64 * kb;
    f32x4 v[8];
#pragma unroll
    for (int i = 0; i < 8; ++i) v[i] = *(const f32x4*)(W + (size_t)(k0 + 8 * i + (lane >> 3)) * N + n0 + 4 * (lane & 7));
#pragma unroll
    for (int i = 0; i < 8; ++i) { float* d = scr + (8 * i + (lane >> 3)) * 33 + 4 * (lane & 7); d[0] = v[i][0]; d[1] = v[i][1]; d[2] = v[i][2]; d[3] = v[i][3]; }
    LDS_WAIT(); asm volatile("" ::: "memory");
    const int c = lane & 7;
#pragma unroll
    for (int j = 0; j < 4; ++j) { const int n = (lane >> 3) + 8 * j; const float* s = scr + (8 * c) * 33 + n;
        u32x4 o; o.x = pk2(s[0 * 33], s[1 * 33]); o.y = pk2(s[2 * 33], s[3 * 33]); o.z = pk2(s[4 * 33], s[5 * 33]); o.w = pk2(s[6 * 33], s[7 * 33]);
        *(u32x4*)(WT + (size_t)(drow0 + n) * K + k0 + 8 * c) = o; }
    LDS_WAIT(); asm volatile("" ::: "memory");
}
__device__ __forceinline__ int il_row(int n0, int which) { return (n0 >> 7) * 256 + which * 128 + (n0 & 127); }

__device__ __forceinline__ void p0_adaln_item(Frame& F, int item) {
    const int layer = item / 96, cb = item % 96;
    float* sl = (float*)F.ldsg;
    float* red = (float*)(F.ldsg + 40960);
    const float* c = F.ap->in[I_C]; const float* cc = F.ap->in[I_CCTX];
    for (int i = F.tid; i < 5 * D; i += 512) { const int r = i / D, k = i % D; const float v = r < 4 ? c[r * D + k] : cc[k]; sl[i] = siluf_(v); }
    __syncthreads();
    const int q4 = 4 * (F.lane & 31), kh = F.lane >> 5;
    const float* W = F.ap->in[I_ADAW] + (size_t)layer * D * NMOD + cb * 128 + q4;
    f32x4 acc[5];
#pragma unroll
    for (int r = 0; r < 5; ++r) acc[r] = (f32x4){0.f, 0.f, 0.f, 0.f};
    const int kbeg = F.wave * 256;
#pragma unroll 1
    for (int k = kbeg; k < kbeg + 256; k += 32) {
        f32x4 w[16];
#pragma unroll
        for (int j = 0; j < 16; ++j) w[j] = *(const f32x4*)(W + (size_t)(k + 2 * j + kh) * NMOD);
#pragma unroll
        for (int j = 0; j < 16; ++j)
#pragma unroll
            for (int r = 0; r < 5; ++r) acc[r] += w[j] * sl[r * D + k + 2 * j + kh];
    }
#pragma unroll
    for (int r = 0; r < 5; ++r) {
#pragma unroll
        for (int c4 = 0; c4 < 4; ++c4) acc[r][c4] += __shfl_xor(acc[r][c4], 32);
        if (kh == 0) *(f32x4*)(red + (F.wave * 5 + r) * 128 + q4) = acc[r]; }
    __syncthreads();
    float* MOD = (float*)(F.ws + WS_MOD);
    for (int i = F.tid; i < 5 * 128; i += 512) { const int r = i / 128, cidx = i % 128; float s = 0.f;
#pragma unroll
        for (int w = 0; w < 8; ++w) s += red[(w * 5 + r) * 128 + cidx];
        const int col = cb * 128 + cidx; MOD[(size_t)(layer * 5 + r) * NMOD + col] = s + F.ap->in[I_ADAB][layer * NMOD + col]; }
    __syncthreads();
}

__device__ __forceinline__ void p0_s5_item(Frame& F, int g) {
    float* Ap = (float*)F.ldsg;
    float* BB = Ap + 2 * 64 * 17 * 2;
    float* Cc = BB + 2 * 64 * 16 * 2;
    float* Kt = Cc + 2 * 16 * 64 * 2;
    const float* lam_re = F.ap->in[I_LAMRE]; const float* lam_im = F.ap->in[I_LAMIM]; const float* lstep = F.ap->in[I_LOGSTEP];
    const float* bre = F.ap->in[I_BRE]; const float* bim = F.ap->in[I_BIM]; const float* cre = F.ap->in[I_CRE]; const float* cim = F.ap->in[I_CIM];
    for (int i = F.tid; i < 2 * 64 * 17; i += 512) { const int l = i % 17, p = (i / 17) % 64, d = i / (17 * 64);
        const float delta = __expf(lstep[d * 64 + g]); const float lr = lam_re[(d * 64 + g) * 64 + p], li = lam_im[(d * 64 + g) * 64 + p];
        const float mag = expf(lr * delta * (float)l); float sn, cs; sincosf(li * delta * (float)l, &sn, &cs);
        Ap[i * 2] = mag * cs; Ap[i * 2 + 1] = mag * sn; }
    for (int i = F.tid; i < 2 * 64 * 16; i += 512) { const int h = i % 16, p = (i / 16) % 64, d = i / (16 * 64);
        const float delta = __expf(lstep[d * 64 + g]); const float lr = lam_re[(d * 64 + g) * 64 + p], li = lam_im[(d * 64 + g) * 64 + p];
        const float x = lr * delta, y = li * delta; float sn, cs; sincosf(y, &sn, &cs); float sh, ch_; sincosf(0.5f * y, &sh, &ch_); (void)ch_;
        const float em1 = expm1f(x); const float are1 = em1 * cs - 2.f * sh * sh;
        const float aim = (em1 + 1.f) * sn; const float den = lr * lr + li * li;
        const float fre = (are1 * lr + aim * li) / den, fim = (aim * lr - are1 * li) / den;
        const size_t bi = ((size_t)((d * 64 + g) * 64 + p)) * 16 + h; const float br = bre[bi], bi_ = bim[bi];
        BB[i * 2] = fre * br - fim * bi_; BB[i * 2 + 1] = fre * bi_ + fim * br; }
    for (int i = F.tid; i < 2 * 16 * 64; i += 512) { const int p = i % 64, h = (i / 64) % 16, d = i / (64 * 16);
        const size_t ci = ((size_t)((d * 64 + g) * 16 + h)) * 64 + p; Cc[i * 2] = cre[ci]; Cc[i * 2 + 1] = cim[ci]; }
    __syncthreads();
    {
        const int h = F.tid % 16, l = (F.tid / 16) % 16, d = F.tid / 256; float s16[16];
#pragma unroll
        for (int hp = 0; hp < 16; ++hp) s16[hp] = 0.f;
#pragma unroll 2
        for (int p = 0; p < 64; ++p) { const f32x2 c2 = *(const f32x2*)(Cc + ((d * 16 + h) * 64 + p) * 2), a2 = *(const f32x2*)(Ap + ((d * 64 + p) * 17 + l) * 2);
            const float tr = c2.x * a2.x - c2.y * a2.y, ti = c2.x * a2.y + c2.y * a2.x; const float* bp = BB + ((d * 64 + p) * 16) * 2;
#pragma unroll
            for (int h4 = 0; h4 < 8; ++h4) { const f32x4 b = *(const f32x4*)(bp + 4 * h4); s16[2 * h4] += tr * b[0] - ti * b[1]; s16[2 * h4 + 1] += tr * b[2] - ti * b[3]; } }
#pragma unroll
        for (int h4 = 0; h4 < 4; ++h4) *(f32x4*)(Kt + ((d * 16 + l) * 16 + h) * 16 + 4 * h4) = (f32x4){s16[4 * h4], s16[4 * h4 + 1], s16[4 * h4 + 2], s16[4 * h4 + 3]}; }
    __syncthreads();
    bf16_t* Wt = (bf16_t*)(F.ws + WS_S5W) + (size_t)g * 256 * 256; bf16_t* Mg = (bf16_t*)(F.ws + WS_S5M) + (size_t)g * 256 * 512;
    for (int v = F.tid; v < 256 * 32; v += 512) { const int n = v >> 5, k0 = (v & 31) * 8; const int d = n >> 7, p = (n >> 1) & 63, ri = n & 1; const int s = k0 >> 4, h0 = k0 & 15, e = d ? s : 15 - s;
        const float ar = Ap[((d * 64 + p) * 17 + e) * 2], ai = Ap[((d * 64 + p) * 17 + e) * 2 + 1]; float o[8];
#pragma unroll
        for (int j = 0; j < 8; ++j) { const float br = BB[((d * 64 + p) * 16 + h0 + j) * 2], bi = BB[((d * 64 + p) * 16 + h0 + j) * 2 + 1]; o[j] = ri ? (ar * bi + ai * br) : (ar * br - ai * bi); }
        u32x4 w; w.x = pk2(o[0], o[1]); w.y = pk2(o[2], o[3]); w.z = pk2(o[4], o[5]); w.w = pk2(o[6], o[7]); *(u32x4*)(Wt + (size_t)n * 256 + k0) = w; }
    for (int v = F.tid; v < 256 * 64; v += 512) { const int n = v >> 6, k0 = (v & 63) * 8; const int t = n >> 4, h = n & 15; float o[8];
        if (k0 < 256) { const int s = k0 >> 4, h0 = k0 & 15;
#pragma unroll
            for (int j = 0; j < 8; ++j) { float x = 0.f; if (s <= t) x += Kt[((0 * 16 + (t - s)) * 16 + h) * 16 + h0 + j]; if (s >= t) x += Kt[((1 * 16 + (s - t)) * 16 + h) * 16 + h0 + j]; o[j] = x; }
        } else { const int d = (k0 - 256) >> 7, e = d ? 16 - t : t + 1;
#pragma unroll
            for (int j = 0; j < 8; ++j) { const int kk = (k0 - 256 - d * 128) + j, p = kk >> 1, ri = kk & 1;
                const float cr = Cc[((d * 16 + h) * 64 + p) * 2], ci = Cc[((d * 16 + h) * 64 + p) * 2 + 1]; const float ar = Ap[((d * 64 + p) * 17 + e) * 2], ai = Ap[((d * 64 + p) * 17 + e) * 2 + 1];
                o[j] = ri ? -(cr * ai + ci * ar) : (cr * ar - ci * ai); } }
        u32x4 w; w.x = pk2(o[0], o[1]); w.y = pk2(o[2], o[3]); w.z = pk2(o[4], o[5]); w.w = pk2(o[6], o[7]); *(u32x4*)(Mg + (size_t)n * 512 + k0) = w; }
    __syncthreads();
}

constexpr int J_IN = 32 * 193, J_OUT = 32 * 64, J_F13 = 32 * 176, J_F2 = 88 * 64, J_M13 = 32 * 224, J_M2 = 112 * 64;
constexpr int Q_L1 = J_IN + J_OUT, Q_ALL = Q_L1 + 16 * J_M13 + 8 * J_M2;
constexpr int TQ2 = 160, TQ9 = 160, TQ10 = 112, TQ12 = 160;
constexpr int TB2 = 0, TB9 = TB2 + 92 * TQ2, TB10 = TB9 + 80 * TQ9, TB12 = TB10 + 128 * TQ10, Q_HID = TB12 + 92 * TQ12;
static_assert(Q_L1 <= TB9 && Q_HID <= Q_ALL, "the layer-1 projection copies must be complete before phase 12");
__device__ __forceinline__ void deferred_item(Frame& F, int r, float* scr) {
    bf16_t* win1 = (bf16_t*)(F.ws + WS_WIN1); bf16_t* wout1 = (bf16_t*)(F.ws + WS_WOUT1); bf16_t* w13m = (bf16_t*)(F.ws + WS_W13M); bf16_t* w2m = (bf16_t*)(F.ws + WS_W2M);
    if (r < J_IN) { p0_transpose_item(F.ap->in[I_OWIN], D, EIN, win1, r / 193, 32 * (r % 193), 32 * (r % 193), scr, F.lane); return; } r -= J_IN;
    if (r < J_OUT) { p0_transpose_item(F.ap->in[I_OWOUT], D, D, wout1, r / 64, 32 * (r % 64), 32 * (r % 64), scr, F.lane); return; } r -= J_OUT;
    if (r < 8 * J_M13) { const int e = r / J_M13, q = r % J_M13, n0 = 32 * (q % 224); p0_transpose_item(F.ap->in[I_MW1] + (size_t)e * D * EXH, D, EXH, w13m + (size_t)e * 2 * EXH * D, q / 224, n0, il_row(n0, 0), scr, F.lane); return; } r -= 8 * J_M13;
    if (r < 8 * J_M13) { const int e = r / J_M13, q = r % J_M13, n0 = 32 * (q % 224); p0_transpose_item(F.ap->in[I_MW3] + (size_t)e * D * EXH, D, EXH, w13m + (size_t)e * 2 * EXH * D, q / 224, n0, il_row(n0, 1), scr, F.lane); return; } r -= 8 * J_M13;
    { const int e = r / J_M2, q = r % J_M2; p0_transpose_item(F.ap->in[I_MW2] + (size_t)e * EXH * D, EXH, D, w2m + (size_t)e * D * EXH, q / 64, 32 * (q % 64), 32 * (q % 64), scr, F.lane); }
}
__device__ __forceinline__ void tail_convert(Frame& F, int base, int per_wg, int rank) {
    if (rank < 0) return;
    float* scr = (float*)(F.ldsg + F.wave * 16384);
    for (int j = 0; j < per_wg; j += 8) deferred_item(F, base + rank * per_wg + j + F.wave, scr);
}
__device__ __forceinline__ void p0_prologue(Frame& F) {
    for (int it = F.bid; it < 256; it += F.G) { if (it < 192) p0_adaln_item(F, it); else p0_s5_item(F, it - 192); }
    __syncthreads();
    float* scr = (float*)(F.ldsg + F.wave * 16384);
    const int gw = F.bid * NWAVES + F.wave, NGW = F.G * NWAVES;
    constexpr int E0 = J_IN, E1 = E0 + J_OUT, E2 = E1 + J_F13, E3 = E2 + J_F13, E4 = E3 + J_F2;
    bf16_t* win0 = (bf16_t*)(F.ws + WS_WIN0); bf16_t* wout0 = (bf16_t*)(F.ws + WS_WOUT0); bf16_t* w130 = (bf16_t*)(F.ws + WS_W130); bf16_t* w20 = (bf16_t*)(F.ws + WS_W20);
    bf16_t* win1 = (bf16_t*)(F.ws + WS_WIN1);
    const int qbeg = (F.G == 256) ? Q_HID : 0;
    for (int it = gw; it < E4 + (Q_ALL - qbeg); it += NGW) {
        int r = it;
        if (r < E0) { p0_transpose_item(F.ap->in[I_EWIN], D, EIN, win0, r / 193, 32 * (r % 193), 32 * (r % 193), scr, F.lane); continue; }
        if (r < E1) { r -= E0; p0_transpose_item(F.ap->in[I_EWOUT], D, D, wout0, r / 64, 32 * (r % 64), 32 * (r % 64), scr, F.lane); continue; }
        if (r < E2) { r -= E1; const int n0 = 32 * (r % 176); p0_transpose_item(F.ap->in[I_FW1], D, FFH, w130, r / 176, n0, il_row(n0, 0), scr, F.lane); continue; }
        if (r < E3) { r -= E2; const int n0 = 32 * (r % 176); p0_transpose_item(F.ap->in[I_FW3], D, FFH, w130, r / 176, n0, il_row(n0, 1), scr, F.lane); continue; }
        if (r < E4) { r -= E3; p0_transpose_item(F.ap->in[I_FW2], FFH, D, w20, r / 64, 32 * (r % 64), 32 * (r % 64), scr, F.lane); continue; }
        deferred_item(F, qbeg + (r - E4), scr);
    }
    { float* RT = (float*)(F.ws + MOE_RT); const float* rw = F.ap->in[I_ROUTER]; for (int i = F.bid * 512 + F.tid; i < 8 * D; i += F.G * 512) RT[i] = rw[(i % D) * 8 + i / D]; }
    { const size_t nvec = (size_t)(EINP - EIN) * D / 8; const u32x4 z = {0u, 0u, 0u, 0u};
      for (size_t i = (size_t)F.bid * 512 + F.tid; i < 2 * nvec; i += (size_t)F.G * 512) { bf16_t* base = i < nvec ? win0 : win1; const size_t j = i < nvec ? i : i - nvec; *(u32x4*)(base + (size_t)EIN * D + j * 8) = z; } }
}

__device__ __forceinline__ void p1_modulate(Frame& F) {
    const int gw = F.bid * NWAVES + F.wave, NGW = F.G * NWAVES;
    const int r_beg = (int)(((long long)gw * MT) / NGW), r_end = (int)(((long long)(gw + 1) * MT) / NGW);
    const float* MOD = (const float*)(F.ws + WS_MOD); bf16_t* A0 = (bf16_t*)(F.ws + WS_A0);
    int l4 = 4 * F.lane; asm volatile("" : "+v"(l4));
    f32x4 S1[8], SH[8], v[8], vn[8]; int cur = -1;
    if (r_beg < r_end) { const float* src = r_beg < NL ? F.ap->in[I_X] + (size_t)r_beg * D : F.ap->in[I_CTX] + (size_t)(r_beg - NL) * D;
#pragma unroll
        for (int j = 0; j < 8; ++j) v[j] = *(const f32x4*)(src + l4 + 256 * j); }
#pragma unroll 1
    for (int r = r_beg; r < r_end; ++r) {
        const int mb = r < NL ? r >> 12 : 4;
        if (mb != cur) { const float* md = MOD + (size_t)mb * NMOD;
#pragma unroll
            for (int j = 0; j < 8; ++j) { SH[j] = *(const f32x4*)(md + l4 + 256 * j); S1[j] = *(const f32x4*)(md + 2048 + l4 + 256 * j) + 1.0f; }
            cur = mb; }
        { const int rn = r + 1 < r_end ? r + 1 : r; const float* src = rn < NL ? F.ap->in[I_X] + (size_t)rn * D : F.ap->in[I_CTX] + (size_t)(rn - NL) * D;
#pragma unroll
          for (int j = 0; j < 8; ++j) vn[j] = *(const f32x4*)(src + l4 + 256 * j); }
#pragma unroll
        for (int j = 0; j < 8; ++j) { const f32x4 y = v[j] * S1[j] + SH[j]; u32x2 w; w.x = pk2(y[0], y[1]); w.y = pk2(y[2], y[3]); *(u32x2*)(A0 + (size_t)r * D + l4 + 256 * j) = w; }
#pragma unroll
        for (int j = 0; j < 8; ++j) v[j] = vn[j];
    }
}
__device__ __forceinline__ void row_stats(const f32x4 (&v)[8], float& mean, float& rstd) {
    float s = 0.f;
#pragma unroll
    for (int j = 0; j < 8; ++j) s += (v[j][0] + v[j][1]) + (v[j][2] + v[j][3]);
    mean = wave_sum(s) * (1.f / D); float q = 0.f;
#pragma unroll
    for (int j = 0; j < 8; ++j) { const f32x4 d = v[j] - mean; q += (d[0] * d[0] + d[1] * d[1]) + (d[2] * d[2] + d[3] * d[3]); }
    rstd = 1.0f / sqrtf(wave_sum(q) * (1.f / D) + EPS);
}
__device__ __forceinline__ void ln_pq(const float* lg, const float* lb, const float* mdsh, const float* mdsc, int l4, f32x4 (&P)[8], f32x4 (&Q)[8]) {
#pragma unroll
    for (int j = 0; j < 8; ++j) { const int c = l4 + 256 * j; const f32x4 gg = *(const f32x4*)(lg + c), bb = *(const f32x4*)(lb + c), sh = *(const f32x4*)(mdsh + c), sc = *(const f32x4*)(mdsc + c) + 1.0f;
        P[j] = gg * sc; Q[j] = bb * sc + sh; }
}
__device__ __forceinline__ void ln_mod_rows(Frame& F, int nrows, const float* lg, const float* lb, int modlayer, int shk, int sck, bf16_t* Aout) {
    const int gw = F.bid * NWAVES + F.wave, NGW = F.G * NWAVES;
    const int r_beg = (int)(((long long)gw * nrows) / NGW), r_end = (int)(((long long)(gw + 1) * nrows) / NGW);
    const float* MOD = (const float*)(F.ws + WS_MOD) + (size_t)modlayer * 5 * NMOD; const float* XR = (const float*)(F.ws + WS_XR);
    int l4 = 4 * F.lane; asm volatile("" : "+v"(l4));
    f32x4 P[8], Q[8], v[8], vn[8]; int cur = -1;
    if (r_beg < r_end) {
#pragma unroll
        for (int j = 0; j < 8; ++j) v[j] = *(const f32x4*)(XR + (size_t)r_beg * D + l4 + 256 * j);
    }
#pragma unroll 1
    for (int r = r_beg; r < r_end; ++r) {
        const int mb = r < NL ? r >> 12 : 4;
        if (mb != cur) { const float* md = MOD + (size_t)mb * NMOD; ln_pq(lg, lb, md + shk * 2048, md + sck * 2048, l4, P, Q); cur = mb; }
        { const int rn = r + 1 < r_end ? r + 1 : r; const float* xn = XR + (size_t)rn * D;
#pragma unroll
          for (int j = 0; j < 8; ++j) vn[j] = *(const f32x4*)(xn + l4 + 256 * j); }
        float mean, rstd; row_stats(v, mean, rstd);
        if (F.lane == 0) *(f32x2*)((float*)(F.ws + MOE_STATS) + (size_t)r * 2) = (f32x2){mean, rstd};
#pragma unroll
        for (int j = 0; j < 8; ++j) { const f32x4 t = (v[j] - mean) * rstd * P[j] + Q[j];
            u32x2 w; w.x = pk2(t[0], t[1]); w.y = pk2(t[2], t[3]); *(u32x2*)(Aout + (size_t)r * D + l4 + 256 * j) = w; }
#pragma unroll
        for (int j = 0; j < 8; ++j) v[j] = vn[j];
    }
}

struct CvWin { u32x2 x[3][6]; };
__device__ __forceinline__ void cv_load(CvWin& wdw, const unsigned char* P, int b, int n, bool isctx, int R, int c0, unsigned lo) {
#pragma unroll
    for (int i = 0; i < 3; ++i)
#pragma unroll
        for (int cc = 0; cc < 6; ++cc) { const int col = c0 + cc - 1; int row = -1;
            if (isctx) { const int t = 64 * n + col; if (i == 1 && t >= 0 && t < CTXL) row = NL + b * CTXL + t; }
            else { const int Rr = R + i - 1; if (Rr >= 0 && Rr < 64 && col >= 0 && col < 64) row = b * SEQ + Rr * 64 + col; }
            u32x2 v = {0u, 0u}; if (row >= 0) v = *(const u32x2*)(P + (size_t)row * (EINP * 2) + lo);
            wdw.x[i][cc] = v; }
}
__device__ __forceinline__ void cv_compute(const CvWin& wdw, const float (&wt)[3][3][4], unsigned char* Q, int row0, int c0, unsigned lo, bool norm, float qs) {
#pragma unroll
    for (int cc = 0; cc < 4; ++cc) { float y0 = 0.f, y1 = 0.f, y2 = 0.f, y3 = 0.f;
#pragma unroll
        for (int i = 0; i < 3; ++i)
#pragma unroll
            for (int j = 0; j < 3; ++j) { const u32x2 x = wdw.x[i][cc + j]; y0 += bflo(x.x) * wt[i][j][0]; y1 += bfhi(x.x) * wt[i][j][1]; y2 += bflo(x.y) * wt[i][j][2]; y3 += bfhi(x.y) * wt[i][j][3]; }
        y0 = siluf_(y0); y1 = siluf_(y1); y2 = siluf_(y2); y3 = siluf_(y3);
        if (norm) { float ss = (y0 * y0 + y1 * y1) + (y2 * y2 + y3 * y3); ss += __shfl_xor(ss, 1); ss += __shfl_xor(ss, 2); ss += __shfl_xor(ss, 4); ss += __shfl_xor(ss, 8); ss += __shfl_xor(ss, 16);
            const float sc = qs * __builtin_amdgcn_rsqf(ss + EPS); y0 *= sc; y1 *= sc; y2 *= sc; y3 *= sc; }
        u32x2 o; o.x = pk2(y0, y1); o.y = pk2(y2, y3);
        *(u32x2*)(Q + (size_t)(row0 + c0 + cc) * (3072 * 2) + lo) = o; }
}
struct CvItem { int b, n, R, row0, ch; unsigned lo; bool isctx, norm; float qs; };
__device__ __forceinline__ void cv_decode(int it, int lane, CvItem& I) {
    const int g12 = it % 12, seg = it / 12; I.b = seg / NCH; I.n = seg % NCH; I.isctx = I.n < 4; I.R = I.n - 4;
    I.ch = g12 * 256 + 4 * lane; I.lo = (unsigned)(I.ch * 2); I.qs = g12 < 4 ? 0.08838834764831845f : 1.0f; I.norm = g12 < 8;
    I.row0 = I.isctx ? NL + I.b * CTXL + 64 * I.n : I.b * SEQ + I.R * 64;
}
__device__ __forceinline__ void cv_weights(const float* cw, int ch, float (&wt)[3][3][4]) {
#pragma unroll
    for (int i = 0; i < 3; ++i)
#pragma unroll
        for (int j = 0; j < 3; ++j) { const f32x4 a0 = *(const f32x4*)(cw + (i * 3 + j) * 3072 + ch); wt[i][j][0] = a0[0]; wt[i][j][1] = a0[1]; wt[i][j][2] = a0[2]; wt[i][j][3] = a0[3]; }
}
__device__ __forceinline__ void p3_dn_conv(Frame& F) {
    const int gw = F.bid * NWAVES + F.wave, NGW = F.G * NWAVES;
    const float* cw = F.ap->in[I_DNCONV];
    const unsigned char* P = F.ws + WS_P; unsigned char* Q = F.ws + WS_QKVN;
    constexpr int NB4 = 272 * 12 * 16;
    int s_beg = (int)(((long long)gw * NB4) / NGW), s_end = (int)(((long long)(gw + 1) * NB4) / NGW);
    if (F.G == 256) {
        const int w = (int)F.bid; const int hb = w < 64 ? 363 * w : 23232 + 423 * (w - 64), he = w < 64 ? 363 * (w + 1) : 23232 + 423 * (w - 63);
        const int wb_ = hb >> 1, we_ = he >> 1; s_beg = wb_ + (we_ - wb_) * F.wave / 8; s_end = wb_ + (we_ - wb_) * (F.wave + 1) / 8; }
    if (s_beg >= s_end) return;
    float wt[3][3][4]; int cur = -1;
    CvItem IA, IB; CvWin wa, wb;
    cv_decode(s_beg >> 4, F.lane, IA); cv_load(wa, P, IA.b, IA.n, IA.isctx, IA.R, 4 * (s_beg & 15), IA.lo);
#pragma unroll 1
    for (int s0 = s_beg; s0 < s_end; s0 += 2) {
        { const int s1 = s0 + 1 < s_end ? s0 + 1 : s0; cv_decode(s1 >> 4, F.lane, IB); cv_load(wb, P, IB.b, IB.n, IB.isctx, IB.R, 4 * (s1 & 15), IB.lo); }
        if ((s0 >> 4) != cur) { cur = s0 >> 4; cv_weights(cw, IA.ch, wt); }
        cv_compute(wa, wt, Q, IA.row0, 4 * (s0 & 15), IA.lo, IA.norm, IA.qs);
        { const int s2 = s0 + 2 < s_end ? s0 + 2 : s0; cv_decode(s2 >> 4, F.lane, IA); cv_load(wa, P, IA.b, IA.n, IA.isctx, IA.R, 4 * (s2 & 15), IA.lo); }
        if (s0 + 1 < s_end) {
            if (((s0 + 1) >> 4) != cur) { cur = (s0 + 1) >> 4; cv_weights(cw, IB.ch, wt); }
            cv_compute(wb, wt, Q, IB.row0, 4 * ((s0 + 1) & 15), IB.lo, IB.norm, IB.qs); }
    }
}

#define WG_BAR() do { asm volatile("s_waitcnt lgkmcnt(0)" ::: "memory"); __builtin_amdgcn_s_barrier(); asm volatile("" ::: "memory"); } while (0)
struct DnIn { u32x4 q[4], k[4], v[4]; float bt, a; };
__device__ __forceinline__ void dnp_load(DnIn& in, Frame& F, int pair, int sub, int ts) {
    const bf16_t* P = (const bf16_t*)(F.ws + WS_P); const bf16_t* Q = (const bf16_t*)(F.ws + WS_QKVN);
    const int item = pair * 2 + sub; const int n = item % NCH, chain = item / NCH, d = chain & 1, h = (chain >> 1) & 7, b = chain >> 4;
#pragma unroll
    for (int j = 0; j < 4; ++j) { const int cidx = ts + 256 * j, i = cidx >> 4, cc = cidx & 15; const bf16_t* src = Q + (size_t)tok_row(b, d, n, i) * 3072 + h * 128 + cc * 8;
        in.q[j] = *(const u32x4*)src; in.k[j] = *(const u32x4*)(src + 1024); in.v[j] = *(const u32x4*)(src + 2048); }
    if (ts < 64) { const int r = tok_row(b, d, n, ts); in.bt = bf1(P[(size_t)r * EINP + 6144 + d * 8 + h]); in.a = bf1(P[(size_t)r * EINP + 6160 + d * 8 + h]); }
}
__device__ __forceinline__ void p4_dn_prep(Frame& F) {
    const int sub = F.tid >> 8, ts = F.tid & 255, ws4 = F.wave & 3, lane = F.lane;
    unsigned char* base = F.ldsg + sub * 69632;
    bf16_t* kL = (bf16_t*)base;
    bf16_t* qL = (bf16_t*)(base + 17408);
    bf16_t* vL = (bf16_t*)(base + 34816);
    float* Lm = (float*)(base + 52224);
    float* sm = (float*)(base + 68608);
    DnIn in;
    if (F.bid < 2176) dnp_load(in, F, F.bid, sub, ts);
#pragma unroll 1
    for (int pair = F.bid; pair < 2176; pair += F.G) {
        const int item = pair * 2 + sub; const int n = item % NCH, chain = item / NCH, d = chain & 1, h = (chain >> 1) & 7;
        unsigned char* ob = F.ws + WS_DNB + (size_t)item * DN_STRIDE;
#pragma unroll
        for (int j = 0; j < 4; ++j) { const int cidx = ts + 256 * j, i = cidx >> 4, cc = cidx & 15; *(u32x4*)(qL + i * 136 + cc * 8) = in.q[j]; *(u32x4*)(kL + i * 136 + cc * 8) = in.k[j]; *(u32x4*)(vL + i * 136 + cc * 8) = in.v[j]; }
        if (ws4 == 0) { const float bt = sigmoidf_(in.bt);
            float gv = -__expf(F.ap->in[I_DNALOG][d * 8 + h]) * softplusf_(in.a + F.ap->in[I_DNDT][d * 8 + h]);
#pragma unroll
            for (int o = 1; o < 64; o <<= 1) { const float t = __shfl_up(gv, o); if (lane >= o) gv += t; }
            sm[lane] = bt; sm[64 + lane] = gv; sm[128 + lane] = __expf(gv); }
        WG_BAR();
        for (int tix = ws4; tix < 10; tix += 4) { const int it = tix >= 6 ? 3 : tix >= 3 ? 2 : tix >= 1 ? 1 : 0, jt = tix - it * (it + 1) / 2;
            f32x4 ak = {0.f, 0.f, 0.f, 0.f}, aq = {0.f, 0.f, 0.f, 0.f};
#pragma unroll
            for (int kk = 0; kk < 4; ++kk) { const bf16x8 fa = *(const bf16x8*)(kL + (16 * jt + (lane & 15)) * 136 + 32 * kk + 8 * (lane >> 4));
                const bf16x8 fk = *(const bf16x8*)(kL + (16 * it + (lane & 15)) * 136 + 32 * kk + 8 * (lane >> 4)); const bf16x8 fq_ = *(const bf16x8*)(qL + (16 * it + (lane & 15)) * 136 + 32 * kk + 8 * (lane >> 4));
                ak = __builtin_amdgcn_mfma_f32_16x16x32_bf16(fa, fk, ak, 0, 0, 0); aq = __builtin_amdgcn_mfma_f32_16x16x32_bf16(fa, fq_, aq, 0, 0, 0); }
            const int i = 16 * it + (lane & 15), j0 = 16 * jt + 4 * (lane >> 4); const float bi = sm[i], gi = sm[64 + i];
            f32x4 lv; float av[4];
#pragma unroll
            for (int q = 0; q < 4; ++q) { const int j = j0 + q; const float dec = __expf(gi - sm[64 + j]); lv[q] = (i > j) ? bi * ak[q] * dec : 0.f; av[q] = (i >= j) ? aq[q] * dec : 0.f; }
            Lm[(j0 + 0) * 64 + i] = lv[0]; Lm[(j0 + 1) * 64 + i] = lv[1]; Lm[(j0 + 2) * 64 + i] = lv[2]; Lm[(j0 + 3) * 64 + i] = lv[3];
            u32x2 w; w.x = pk2(av[0], av[1]); w.y = pk2(av[2], av[3]); *(u32x2*)(ob + DN_ATT + (size_t)(i * 64 + j0) * 2) = w; }
        {
            const int it = ws4; const u32x2 z = {0u, 0u};
            for (int jt = it + 1; jt < 4; ++jt) { const int i = 16 * it + (lane & 15), j0 = 16 * jt + 4 * (lane >> 4); *(u32x2*)(ob + DN_ATT + (size_t)(i * 64 + j0) * 2) = z; } }
        WG_BAR();
        f32x2 sp[32];
        if (ts < 128) {
#pragma unroll
            for (int m = 0; m < 32; ++m) sp[m] = (f32x2){bf1(vL[(2 * m) * 136 + ts]) * sm[2 * m], bf1(vL[(2 * m + 1) * 136 + ts]) * sm[2 * m + 1]};
        } else {
#pragma unroll
            for (int m = 0; m < 32; ++m) sp[m] = (f32x2){bf1(kL[(2 * m) * 136 + ts - 128]) * sm[2 * m] * sm[128 + 2 * m], bf1(kL[(2 * m + 1) * 136 + ts - 128]) * sm[2 * m + 1] * sm[128 + 2 * m + 1]};
        }
        {
#pragma unroll
            for (int j = 0; j < 63; ++j) { f32x4 Lr[16];
#pragma unroll
                for (int g = (j + 1) / 4; g < 16; ++g) Lr[g] = *(const f32x4*)(Lm + j * 64 + 4 * g);
                __builtin_amdgcn_sched_barrier(0);
                const float sj = (j & 1) ? sp[j >> 1].y : sp[j >> 1].x; const f32x2 s2 = {sj, sj};
#pragma unroll
                for (int g = (j + 1) / 4; g < 16; ++g) {
                    if (4 * g + 1 > j) sp[2 * g] -= (f32x2){Lr[g][0], Lr[g][1]} * s2;
                    if (4 * g + 3 > j) sp[2 * g + 1] -= (f32x2){Lr[g][2], Lr[g][3]} * s2; }
                __builtin_amdgcn_sched_barrier(0); }
        }
        float sol[64];
#pragma unroll
        for (int m = 0; m < 32; ++m) { sol[2 * m] = sp[m].x; sol[2 * m + 1] = sp[m].y; }
        if (ts < 128) {
#pragma unroll
            for (int i8 = 0; i8 < 8; ++i8) { u32x4 w; w.x = pk2(sol[8 * i8], sol[8 * i8 + 1]); w.y = pk2(sol[8 * i8 + 2], sol[8 * i8 + 3]); w.z = pk2(sol[8 * i8 + 4], sol[8 * i8 + 5]); w.w = pk2(sol[8 * i8 + 6], sol[8 * i8 + 7]);
                *(u32x4*)(ob + DN_UT + (size_t)(ts * 64 + 8 * i8) * 2) = w; }
        }
        if (pair + F.G < 2176) dnp_load(in, F, pair + F.G, sub, ts);
#pragma unroll
        for (int j = 0; j < 4; ++j) { const int cidx = ts + 256 * j, i = cidx >> 4, cc = cidx & 15; const u32x4 qv = *(const u32x4*)(qL + i * 136 + cc * 8); const float e = sm[128 + i];
            u32x4 w; w.x = pk2(bflo(qv.x) * e, bfhi(qv.x) * e); w.y = pk2(bflo(qv.y) * e, bfhi(qv.y) * e); w.z = pk2(bflo(qv.z) * e, bfhi(qv.z) * e); w.w = pk2(bflo(qv.w) * e, bfhi(qv.w) * e);
            *(u32x4*)(ob + DN_QG + (size_t)(i * 128 + cc * 8) * 2) = w; }
        WG_BAR();
        if (ts >= 128) {
#pragma unroll
            for (int i = 0; i < 64; ++i) qL[i * 136 + ts - 128] = (bf16_t)f2bf(sol[i]);
        }
        unsigned char* KS = (unsigned char*)Lm;
        { const int dk = ts & 127, ih = ts >> 7; const float gl = sm[64 + 63];
#pragma unroll
          for (int i8 = 0; i8 < 4; ++i8) { float o[8];
#pragma unroll
              for (int q = 0; q < 8; ++q) { const int i = 32 * ih + 8 * i8 + q; o[q] = bf1(kL[i * 136 + dk]) * __expf(gl - sm[64 + i]); }
              u32x4 w; w.x = pk2(o[0], o[1]); w.y = pk2(o[2], o[3]); w.z = pk2(o[4], o[5]); w.w = pk2(o[6], o[7]);
              *(u32x4*)(KS + dk * 128 + 16 * ((4 * ih + i8) ^ (dk & 7))) = w; }
          if (ts == 0) *(float*)(ob + DN_GL) = __expf(gl); }
        WG_BAR();
#pragma unroll
        for (int j = 0; j < 4; ++j) { const int cidx = ts + 256 * j, i = cidx >> 4, cc = cidx & 15; *(u32x4*)(ob + DN_W + (size_t)(i * 128 + cc * 8) * 2) = *(const u32x4*)(qL + i * 136 + cc * 8);
            const int r = cidx >> 3, p = cidx & 7; *(u32x4*)(ob + DN_KGT + (size_t)(r * 64 + 8 * p) * 2) = *(const u32x4*)(KS + r * 128 + 16 * (p ^ (r & 7))); }
        WG_BAR();
    }
}

constexpr int DN_LVT = 17408, DN_OB = 26624, DN_OBP = 68, DN_LW = 61440, DN_LQG = 78848, DN_LAT = 96256, DN_LKG = 105472, DN_LUT = 123904;
struct DnStage { u32x4 w[2], qg[2], kg[2], at, ut; float gl; };
__device__ __forceinline__ void dn_stage_load(DnStage& st, const unsigned char* ib, int sl, int tid) {
    const unsigned o = (unsigned)tid * 16u;
    st.gl = *(const float*)(ib + DN_GL);
#pragma unroll
    for (int j = 0; j < 2; ++j) { st.w[j] = *(const u32x4*)(ib + DN_W + 8192 * j + o); st.qg[j] = *(const u32x4*)(ib + DN_QG + 8192 * j + o); st.kg[j] = *(const u32x4*)(ib + DN_KGT + 8192 * j + o); }
    st.at = *(const u32x4*)(ib + DN_ATT + o);
    st.ut = *(const u32x4*)(ib + DN_UT + 8192 * sl + o);
}
__device__ __forceinline__ void dn_stage_store(const DnStage& st, unsigned char* lds, int tid) {
#pragma unroll
    for (int j = 0; j < 2; ++j) { const int cidx = tid + 512 * j; *(u32x4*)(lds + DN_LW + (cidx >> 4) * 272 + (cidx & 15) * 16) = st.w[j]; *(u32x4*)(lds + DN_LQG + (cidx >> 4) * 272 + (cidx & 15) * 16) = st.qg[j];
        *(u32x4*)(lds + DN_LKG + (cidx >> 3) * 144 + (cidx & 7) * 16) = st.kg[j]; }
    *(u32x4*)(lds + DN_LAT + (tid >> 3) * 144 + (tid & 7) * 16) = st.at;
    *(u32x4*)(lds + DN_LUT + (tid >> 3) * 144 + (tid & 7) * 16) = st.ut;
}
__device__ __forceinline__ void dn_flush(Frame& F, int nlast, int b, int d, int h, int sl) {
    const float* Ob = (const float*)(F.ldsg + DN_OB); bf16_t* O = (bf16_t*)(F.ws + WS_ODN);
#pragma unroll
    for (int j = 0; j < 2; ++j) { const int idx = F.tid + 512 * j, c8 = idx & 7, pos = (idx >> 3) & 63, sn = idx >> 9;
        const f32x4 v0 = *(const f32x4*)(Ob + (sn * 64 + pos) * DN_OBP + 8 * c8), v1 = *(const f32x4*)(Ob + (sn * 64 + pos) * DN_OBP + 8 * c8 + 4); const int r = tok_row(b, d, nlast - 1 + sn, pos);
        u32x4 w; w.x = pk2(v0[0], v0[1]); w.y = pk2(v0[2], v0[3]); w.z = pk2(v1[0], v1[1]); w.w = pk2(v1[2], v1[3]);
        *(u32x4*)(O + ((size_t)d * MT + r) * 1024 + h * 128 + 64 * sl + 8 * c8) = w; }
}
__device__ __forceinline__ void p5_dn_scan(Frame& F, int G2, int c2) {
    unsigned char* L = F.ldsg; bf16_t* St = (bf16_t*)L; bf16_t* Vt = (bf16_t*)(L + DN_LVT); float* Ob = (float*)(L + DN_OB);
    const int w = F.wave, lr = F.lane & 15, lq = F.lane >> 4, pt = w >> 1, cth = w & 1;
    for (int unit = c2; unit < 128; unit += G2) {
        const int sl = unit & 1, chain = unit >> 1, d = chain & 1, h = (chain >> 1) & 7, b = chain >> 4;
        f32x4 accS[4];
#pragma unroll
        for (int c4 = 0; c4 < 4; ++c4) accS[c4] = (f32x4){0.f, 0.f, 0.f, 0.f};
        for (int i = F.tid; i < 17408 / 4; i += 512) ((unsigned*)St)[i] = 0u;
        const unsigned char* ib0 = F.ws + WS_DNB + (size_t)(chain * NCH) * DN_STRIDE;
        DnStage sgA, sgB; dn_stage_load(sgA, ib0, sl, F.tid); dn_stage_load(sgB, ib0 + DN_STRIDE, sl, F.tid);
#pragma unroll 1
        for (int t = 0; t < NCH; t += 2) {
            {
            const float gl = sgA.gl;
            dn_stage_store(sgA, L, F.tid);
            if (t && (t & 1) == 0) dn_flush(F, t - 1, b, d, h, sl);
            dn_stage_load(sgA, ib0 + (size_t)(t + 2 < NCH ? t + 2 : NCH - 1) * DN_STRIDE, sl, F.tid);
            WG_BAR();
            f32x4 aw[2] = {{0.f, 0.f, 0.f, 0.f}, {0.f, 0.f, 0.f, 0.f}}, ao[2] = {{0.f, 0.f, 0.f, 0.f}, {0.f, 0.f, 0.f, 0.f}};
#pragma unroll
            for (int kk = 0; kk < 4; ++kk) { const bf16x8 fw = *(const bf16x8*)(L + DN_LW + (16 * pt + lr) * 272 + 64 * kk + 16 * lq), fqg = *(const bf16x8*)(L + DN_LQG + (16 * pt + lr) * 272 + 64 * kk + 16 * lq);
#pragma unroll
                for (int c2i = 0; c2i < 2; ++c2i) { const bf16x8 fs = *(const bf16x8*)(St + (16 * (2 * cth + c2i) + lr) * 136 + 32 * kk + 8 * lq);
                    aw[c2i] = __builtin_amdgcn_mfma_f32_16x16x32_bf16(fw, fs, aw[c2i], 0, 0, 0); ao[c2i] = __builtin_amdgcn_mfma_f32_16x16x32_bf16(fqg, fs, ao[c2i], 0, 0, 0); } }
#pragma unroll
            for (int c2i = 0; c2i < 2; ++c2i) { const int ct = 2 * cth + c2i; const u32x2 uu = *(const u32x2*)(L + DN_LUT + (16 * ct + lr) * 144 + (16 * pt + 4 * lq) * 2);
                const float v0 = bflo(uu.x) - aw[c2i][0], v1 = bfhi(uu.x) - aw[c2i][1], v2 = bflo(uu.y) - aw[c2i][2], v3 = bfhi(uu.y) - aw[c2i][3];
                u32x2 vv; vv.x = pk2(v0, v1); vv.y = pk2(v2, v3); *(u32x2*)(Vt + (16 * ct + lr) * 72 + 16 * pt + 4 * lq) = vv; }
            WG_BAR();
            bf16x8 fv[4][2];
#pragma unroll
            for (int c4 = 0; c4 < 4; ++c4)
#pragma unroll
                for (int kk = 0; kk < 2; ++kk) fv[c4][kk] = *(const bf16x8*)(Vt + (16 * c4 + lr) * 72 + 32 * kk + 8 * lq);
#pragma unroll
            for (int kk = 0; kk < 2; ++kk) { const bf16x8 fat = *(const bf16x8*)(L + DN_LAT + (16 * pt + lr) * 144 + 64 * kk + 16 * lq);
#pragma unroll
                for (int c2i = 0; c2i < 2; ++c2i) { const bf16x8 fb = *(const bf16x8*)(Vt + (16 * (2 * cth + c2i) + lr) * 72 + 32 * kk + 8 * lq); ao[c2i] = __builtin_amdgcn_mfma_f32_16x16x32_bf16(fat, fb, ao[c2i], 0, 0, 0); } }
            { bf16x8 fkg[2];
#pragma unroll
              for (int kk = 0; kk < 2; ++kk) fkg[kk] = *(const bf16x8*)(L + DN_LKG + (16 * w + lr) * 144 + 64 * kk + 16 * lq);
#pragma unroll
              for (int c4 = 0; c4 < 4; ++c4) { accS[c4] = accS[c4] * gl;
#pragma unroll
                  for (int kk = 0; kk < 2; ++kk) accS[c4] = __builtin_amdgcn_mfma_f32_16x16x32_bf16(fkg[kk], fv[c4][kk], accS[c4], 0, 0, 0);
                  u32x2 sv; sv.x = pk2(accS[c4][0], accS[c4][1]); sv.y = pk2(accS[c4][2], accS[c4][3]); *(u32x2*)(St + (16 * c4 + lr) * 136 + 16 * w + 4 * lq) = sv; } }
#pragma unroll
            for (int c2i = 0; c2i < 2; ++c2i)
#pragma unroll
                for (int q = 0; q < 4; ++q) Ob[((t & 1) * 64 + 16 * pt + 4 * lq + q) * DN_OBP + 16 * (2 * cth + c2i) + lr] = ao[c2i][q];
            WG_BAR();
            }
            {
            const float gl = sgB.gl;
            dn_stage_store(sgB, L, F.tid);
            if ((t + 1) && ((t + 1) & 1) == 0) dn_flush(F, (t + 1) - 1, b, d, h, sl);
            dn_stage_load(sgB, ib0 + (size_t)((t + 1) + 2 < NCH ? (t + 1) + 2 : NCH - 1) * DN_STRIDE, sl, F.tid);
            WG_BAR();
            f32x4 aw[2] = {{0.f, 0.f, 0.f, 0.f}, {0.f, 0.f, 0.f, 0.f}}, ao[2] = {{0.f, 0.f, 0.f, 0.f}, {0.f, 0.f, 0.f, 0.f}};
#pragma unroll
            for (int kk = 0; kk < 4; ++kk) { const bf16x8 fw = *(const bf16x8*)(L + DN_LW + (16 * pt + lr) * 272 + 64 * kk + 16 * lq), fqg = *(const bf16x8*)(L + DN_LQG + (16 * pt + lr) * 272 + 64 * kk + 16 * lq);
#pragma unroll
                for (int c2i = 0; c2i < 2; ++c2i) { const bf16x8 fs = *(const bf16x8*)(St + (16 * (2 * cth + c2i) + lr) * 136 + 32 * kk + 8 * lq);
                    aw[c2i] = __builtin_amdgcn_mfma_f32_16x16x32_bf16(fw, fs, aw[c2i], 0, 0, 0); ao[c2i] = __builtin_amdgcn_mfma_f32_16x16x32_bf16(fqg, fs, ao[c2i], 0, 0, 0); } }
#pragma unroll
            for (int c2i = 0; c2i < 2; ++c2i) { const int ct = 2 * cth + c2i; const u32x2 uu = *(const u32x2*)(L + DN_LUT + (16 * ct + lr) * 144 + (16 * pt + 4 * lq) * 2);
                const float v0 = bflo(uu.x) - aw[c2i][0], v1 = bfhi(uu.x) - aw[c2i][1], v2 = bflo(uu.y) - aw[c2i][2], v3 = bfhi(uu.y) - aw[c2i][3];
                u32x2 vv; vv.x = pk2(v0, v1); vv.y = pk2(v2, v3); *(u32x2*)(Vt + (16 * ct + lr) * 72 + 16 * pt + 4 * lq) = vv; }
            WG_BAR();
            bf16x8 fv[4][2];
#pragma unroll
            for (int c4 = 0; c4 < 4; ++c4)
#pragma unroll
                for (int kk = 0; kk < 2; ++kk) fv[c4][kk] = *(const bf16x8*)(Vt + (16 * c4 + lr) * 72 + 32 * kk + 8 * lq);
#pragma unroll
            for (int kk = 0; kk < 2; ++kk) { const bf16x8 fat = *(const bf16x8*)(L + DN_LAT + (16 * pt + lr) * 144 + 64 * kk + 16 * lq);
#pragma unroll
                for (int c2i = 0; c2i < 2; ++c2i) { const bf16x8 fb = *(const bf16x8*)(Vt + (16 * (2 * cth + c2i) + lr) * 72 + 32 * kk + 8 * lq); ao[c2i] = __builtin_amdgcn_mfma_f32_16x16x32_bf16(fat, fb, ao[c2i], 0, 0, 0); } }
            { bf16x8 fkg[2];
#pragma unroll
              for (int kk = 0; kk < 2; ++kk) fkg[kk] = *(const bf16x8*)(L + DN_LKG + (16 * w + lr) * 144 + 64 * kk + 16 * lq);
#pragma unroll
              for (int c4 = 0; c4 < 4; ++c4) { accS[c4] = accS[c4] * gl;
#pragma unroll
                  for (int kk = 0; kk < 2; ++kk) accS[c4] = __builtin_amdgcn_mfma_f32_16x16x32_bf16(fkg[kk], fv[c4][kk], accS[c4], 0, 0, 0);
                  u32x2 sv; sv.x = pk2(accS[c4][0], accS[c4][1]); sv.y = pk2(accS[c4][2], accS[c4][3]); *(u32x2*)(St + (16 * c4 + lr) * 136 + 16 * w + 4 * lq) = sv; } }
#pragma unroll
            for (int c2i = 0; c2i < 2; ++c2i)
#pragma unroll
                for (int q = 0; q < 4; ++q) Ob[(((t + 1) & 1) * 64 + 16 * pt + 4 * lq + q) * DN_OBP + 16 * (2 * cth + c2i) + lr] = ao[c2i][q];
            WG_BAR();
            }
        }
        dn_flush(F, NCH - 1, b, d, h, sl);
        WG_BAR();
    }
}
__device__ __forceinline__ void p6_dn_post(Frame& F) {
    const int gw = F.bid * NWAVES + F.wave, NGW = F.G * NWAVES;
    const int r_beg = (int)(((long long)gw * MT) / NGW), r_end = (int)(((long long)(gw + 1) * MT) / NGW);
    const bf16_t* O = (const bf16_t*)(F.ws + WS_ODN); const bf16_t* P = (const bf16_t*)(F.ws + WS_P); bf16_t* A1 = (bf16_t*)(F.ws + WS_A1); const float* nw = F.ap->in[I_DNNORM];
    int c0 = 16 * F.lane; asm volatile("" : "+v"(c0));
    float nwr[16];
#pragma unroll
    for (int q = 0; q < 16; ++q) nwr[q] = nw[(c0 + q) & 127];
    u32x4 a[2], bq[2], zv[2], an[2], bn[2], zn[2];
    if (r_beg < r_end) {
#pragma unroll
        for (int j = 0; j < 2; ++j) { a[j] = *(const u32x4*)(O + (size_t)r_beg * 1024 + c0 + 8 * j); bq[j] = *(const u32x4*)(O + ((size_t)MT + r_beg) * 1024 + c0 + 8 * j); zv[j] = *(const u32x4*)(P + (size_t)r_beg * EINP + 3072 + c0 + 8 * j); }
    }
#pragma unroll 1
    for (int r = r_beg; r < r_end; ++r) {
        { const int rn = r + 1 < r_end ? r + 1 : r;
#pragma unroll
          for (int j = 0; j < 2; ++j) { an[j] = *(const u32x4*)(O + (size_t)rn * 1024 + c0 + 8 * j); bn[j] = *(const u32x4*)(O + ((size_t)MT + rn) * 1024 + c0 + 8 * j); zn[j] = *(const u32x4*)(P + (size_t)rn * EINP + 3072 + c0 + 8 * j); } }
        float o[16], z[16]; float ss = 0.f;
#pragma unroll
        for (int j = 0; j < 2; ++j) {
            o[8 * j + 0] = bflo(a[j].x) + bflo(bq[j].x); o[8 * j + 1] = bfhi(a[j].x) + bfhi(bq[j].x); o[8 * j + 2] = bflo(a[j].y) + bflo(bq[j].y); o[8 * j + 3] = bfhi(a[j].y) + bfhi(bq[j].y);
            o[8 * j + 4] = bflo(a[j].z) + bflo(bq[j].z); o[8 * j + 5] = bfhi(a[j].z) + bfhi(bq[j].z); o[8 * j + 6] = bflo(a[j].w) + bflo(bq[j].w); o[8 * j + 7] = bfhi(a[j].w) + bfhi(bq[j].w);
            z[8 * j + 0] = bflo(zv[j].x); z[8 * j + 1] = bfhi(zv[j].x); z[8 * j + 2] = bflo(zv[j].y); z[8 * j + 3] = bfhi(zv[j].y); z[8 * j + 4] = bflo(zv[j].z); z[8 * j + 5] = bfhi(zv[j].z); z[8 * j + 6] = bflo(zv[j].w); z[8 * j + 7] = bfhi(zv[j].w); }
#pragma unroll
        for (int q = 0; q < 16; ++q) ss += o[q] * o[q];
        ss += __shfl_xor(ss, 1); ss += __shfl_xor(ss, 2); ss += __shfl_xor(ss, 4);
        const float rstd = 1.0f / sqrtf(ss * (1.f / 128.f) + EPS);
        float y[16];
#pragma unroll
        for (int q = 0; q < 16; ++q) y[q] = o[q] * rstd * nwr[q] * siluf_(z[q]);
        u32x4 w0, w1; w0.x = pk2(y[0], y[1]); w0.y = pk2(y[2], y[3]); w0.z = pk2(y[4], y[5]); w0.w = pk2(y[6], y[7]); w1.x = pk2(y[8], y[9]); w1.y = pk2(y[10], y[11]); w1.z = pk2(y[12], y[13]); w1.w = pk2(y[14], y[15]);
        *(u32x4*)(A1 + (size_t)r * D + 1024 + c0) = w0; *(u32x4*)(A1 + (size_t)r * D + 1024 + c0 + 8) = w1;
#pragma unroll
        for (int j = 0; j < 2; ++j) { a[j] = an[j]; bq[j] = bn[j]; zv[j] = zn[j]; }
    }
}

__device__ __forceinline__ void p4_s5_scan(Frame& F) {
    const float* E = (const float*)(F.ws + WS_E); bf16_t* As5 = (bf16_t*)(F.ws + WS_AS5);
    const bool two = F.G == 256; const int tl = two ? (F.tid & 127) : F.tid;
    for (int gb = two ? (F.bid >= 128 ? 2 * ((int)F.bid - 128) + (F.tid >> 7) : 256) : (int)F.bid; gb < 256; gb += two ? 256 : F.G) {
        if (two ? (F.tid < 256) : (F.tid < 128)) {
            const int g = gb >> 2, b = gb & 3, p = tl & 63, d = tl >> 6;
            const float delta = __expf(F.ap->in[I_LOGSTEP][d * 64 + g]); const float lr = F.ap->in[I_LAMRE][(d * 64 + g) * 64 + p], li = F.ap->in[I_LAMIM][(d * 64 + g) * 64 + p];
            const float mag = expf(16.f * lr * delta); float sn, cs; sincosf(16.f * li * delta, &sn, &cs); const float ar = mag * cs, ai = mag * sn;
            float hr = 0.f, hi = 0.f;
            const size_t rowbase = (size_t)g * S5ROWS + b;
            f32x2 ea[16], eb[16];
#pragma unroll
            for (int q = 0; q < 16; ++q) { const int chunk = d ? 15 - q : q; ea[q] = *(const f32x2*)(E + (rowbase + chunk * 4) * 256 + d * 128 + p * 2); }
#pragma unroll 1
            for (int i0 = 0; i0 < S5CH; i0 += 32) {
#pragma unroll
                for (int q = 0; q < 16; ++q) { const int idx = i0 + 16 + q, chunk = d ? (idx < 16 ? 15 - idx : 287 - idx) : idx; eb[q] = *(const f32x2*)(E + (rowbase + (idx < S5CH ? chunk : 0) * 4) * 256 + d * 128 + p * 2); }
#pragma unroll
                for (int q = 0; q < 16; ++q) { const int idx = i0 + q, chunk = d ? (idx < 16 ? 15 - idx : 287 - idx) : idx;
                    *(unsigned*)(As5 + (rowbase + chunk * 4) * 512 + 256 + d * 128 + p * 2) = pk2(hr, hi);
                    const float nr = ar * hr - ai * hi + ea[q].x, ni = ar * hi + ai * hr + ea[q].y; hr = nr; hi = ni; }
                if (i0 + 16 < S5CH) {
#pragma unroll
                    for (int q = 0; q < 16; ++q) { const int idx = i0 + 32 + q, chunk = d ? (idx < 16 ? 15 - idx : 287 - idx) : idx; ea[q] = *(const f32x2*)(E + (rowbase + (idx < S5CH ? chunk : 0) * 4) * 256 + d * 128 + p * 2); }
#pragma unroll
                    for (int q = 0; q < 16; ++q) { const int idx = i0 + 16 + q, chunk = d ? (idx < 16 ? 15 - idx : 287 - idx) : idx;
                        *(unsigned*)(As5 + (rowbase + chunk * 4) * 512 + 256 + d * 128 + p * 2) = pk2(hr, hi);
                        const float nr = ar * hr - ai * hi + eb[q].x, ni = ar * hi + ai * hr + eb[q].y; hr = nr; hi = ni; }
                }
            }
        }
    }
}

__device__ __forceinline__ int chunk_row0(int b, int n) { return n < 4 ? NL + b * CTXL + 64 * n : b * SEQ + 64 * (n - 4); }
struct GpIn { u32x4 q[4], k[4], lr; float gw[16], gb; };
__device__ __forceinline__ void gp_load(GpIn& in, Frame& F, int item, int c) {
    const bf16_t* P = (const bf16_t*)(F.ws + WS_P);
    const int n = item % NCH, chain = item / NCH, d = chain & 1, h = (chain >> 1) & 3, b = chain >> 3; const int r0 = chunk_row0(b, n);
#pragma unroll
    for (int j = 0; j < 4; ++j) { const int cidx = F.tid + 512 * j, pos = cidx >> 5, cc = cidx & 31; const bf16_t* src = P + (size_t)(r0 + pos) * EINP + h * 256 + cc * 8;
        in.q[j] = *(const u32x4*)src; in.k[j] = *(const u32x4*)(src + 1024); }
    { const int t = F.tid & 127, pos = t >> 1, hf = t & 1; in.lr = *(const u32x4*)(P + (size_t)(r0 + pos) * EINP + 6144 + d * 16 + hf * 8); }
#pragma unroll
    for (int j = 0; j < 16; ++j) in.gw[j] = F.ap->in[I_GLAW2][(d * 16 + j) * 1024 + h * 256 + c];
    in.gb = F.ap->in[I_GLAB][d * 1024 + h * 256 + c];
}
__device__ __forceinline__ void p13_gla_prep(Frame& F) {
    const bf16_t* P = (const bf16_t*)(F.ws + WS_P);
    const int lane = F.lane, w = F.wave;
    {
        const int db = w * 8 + (lane >> 3), pb = lane & 7;
        u32x4 R[8], Rn[8];
        int first = (int)F.bid, step = (int)F.G, end = 1088;
        if (F.G == 256) { if (F.bid < 128) { first = 2 * (int)F.bid; step = 1; end = first + 2; } else { first = 256 + ((int)F.bid - 128); step = 128; end = 1088; } }
        if (first < end) { const int n = first % NCH, bh = first / NCH, h = bh & 3, b = bh >> 2; const int r0 = chunk_row0(b, n);
#pragma unroll
            for (int q = 0; q < 8; ++q) R[q] = *(const u32x4*)(P + (size_t)(r0 + 8 * pb + q) * EINP + 2048 + h * 512 + 8 * db); }
#pragma unroll 1
        for (int item = first; item < end; item += step) {
            { const int nx = item + step < end ? item + step : item; const int n = nx % NCH, bh = nx / NCH, h = bh & 3, b = bh >> 2; const int r0 = chunk_row0(b, n);
#pragma unroll
              for (int q = 0; q < 8; ++q) Rn[q] = *(const u32x4*)(P + (size_t)(r0 + 8 * pb + q) * EINP + 2048 + h * 512 + 8 * db); }
            bf16_t* vt = (bf16_t*)(F.ws + WS_GLV + (size_t)item * GLV_STRIDE);
#pragma unroll
            for (int j = 0; j < 8; ++j) { u32x4 c;
#pragma unroll
                for (int m = 0; m < 4; ++m) { const unsigned lo = R[2 * m][j >> 1], hi = R[2 * m + 1][j >> 1]; c[m] = (j & 1) ? __builtin_amdgcn_perm(hi, lo, 0x07060302u) : __builtin_amdgcn_perm(hi, lo, 0x05040100u); }
                *(u32x4*)(vt + (size_t)(8 * db + j) * 64 + 8 * pb) = c; }
#pragma unroll
            for (int q = 0; q < 8; ++q) R[q] = Rn[q];
        }
    }
    bf16_t* qL = (bf16_t*)F.ldsg;
    bf16_t* kL = (bf16_t*)(F.ldsg + 33792);
    bf16_t* kdT = (bf16_t*)(F.ldsg + 67584);
    float* lrL = (float*)(F.ldsg + 104448);
    float* tot = (float*)(F.ldsg + 108544);
    const int c = F.tid & 255, ph = F.tid >> 8;
    __syncthreads();
    GpIn in;
    if (F.bid < 2176) gp_load(in, F, F.bid, c);
#pragma unroll 1
    for (int item = F.bid; item < 2176; item += F.G) {
        const int n = item % NCH, chain = item / NCH, d = chain & 1; (void)n;
        unsigned char* ob = F.ws + WS_GLB + (size_t)item * GL_STRIDE;
#pragma unroll
        for (int j = 0; j < 4; ++j) { const int cidx = F.tid + 512 * j, pos = cidx >> 5, cc = cidx & 31; *(u32x4*)(qL + pos * 264 + cc * 8) = in.q[j]; *(u32x4*)(kL + pos * 264 + cc * 8) = in.k[j]; }
        if (F.tid < 128) { const int pos = F.tid >> 1, hf = F.tid & 1; const u32x4 v = in.lr; float* dst = lrL + pos * 16 + hf * 8;
            dst[0] = bflo(v.x); dst[1] = bfhi(v.x); dst[2] = bflo(v.y); dst[3] = bfhi(v.y); dst[4] = bflo(v.z); dst[5] = bfhi(v.z); dst[6] = bflo(v.w); dst[7] = bfhi(v.w); }
        float gw[16];
#pragma unroll
        for (int j = 0; j < 16; ++j) gw[j] = in.gw[j];
        const float gb = in.gb;
        gp_load(in, F, item + F.G < 2176 ? item + F.G : item, c);
        WG_BAR();
        float pre[32]; float run = 0.f;
#pragma unroll
        for (int i = 0; i < 32; ++i) { const int pos = 32 * ph + i; float z = gb;
#pragma unroll
            for (int j4 = 0; j4 < 4; ++j4) { const f32x4 l4 = *(const f32x4*)(lrL + pos * 16 + 4 * j4); z += l4[0] * gw[4 * j4] + l4[1] * gw[4 * j4 + 1] + l4[2] * gw[4 * j4 + 2] + l4[3] * gw[4 * j4 + 3]; }
            const float ls = fminf(z, 0.f) - __logf(1.0f + __expf(-fabsf(z))); run += ls * 0.0625f; pre[i] = run; }
        tot[ph * 256 + c] = run;
        WG_BAR();
        const float off = ph ? tot[c] : 0.f; const float cl = tot[c] + tot[256 + c]; const float ecl = __expf(cl);
#pragma unroll
        for (int i8 = 0; i8 < 4; ++i8) { float kd[8];
#pragma unroll
            for (int q = 0; q < 8; ++q) { const int i = 8 * i8 + q, pos = 32 * ph + i;
                const float cv = d ? (cl - (off + pre[i]) + (pre[i] - (i ? pre[i - 1] : 0.f))) : (off + pre[i]);
                const float e = __expf(cv), rcp = __builtin_amdgcn_rcpf(e);
                const float qv = bf1(qL[pos * 264 + c]) * 0.0625f, kv = bf1(kL[pos * 264 + c]);
                qL[pos * 264 + c] = (bf16_t)f2bf(qv * e); const float ki = kv * rcp; kL[pos * 264 + c] = (bf16_t)f2bf(ki); kd[q] = ki * ecl; }
            u32x4 wv; wv.x = pk2(kd[0], kd[1]); wv.y = pk2(kd[2], kd[3]); wv.z = pk2(kd[4], kd[5]); wv.w = pk2(kd[6], kd[7]);
            *(u32x4*)(kdT + c * 72 + 32 * ph + 8 * i8) = wv; }
        if (ph == 0) *(float*)(ob + GL_GL + (size_t)c * 4) = ecl;
        WG_BAR();
        for (int tix = w; tix < 10; tix += 8) { const int ta = tix >= 6 ? 3 : tix >= 3 ? 2 : tix >= 1 ? 1 : 0, tb = tix - ta * (ta + 1) / 2; const int it = d ? tb : ta, jt = d ? ta : tb;
            f32x4 a = {0.f, 0.f, 0.f, 0.f};
#pragma unroll
            for (int kk = 0; kk < 8; ++kk) { const bf16x8 fa = *(const bf16x8*)(kL + (16 * jt + (lane & 15)) * 264 + 32 * kk + 8 * (lane >> 4)); const bf16x8 fb = *(const bf16x8*)(qL + (16 * it + (lane & 15)) * 264 + 32 * kk + 8 * (lane >> 4));
                a = __builtin_amdgcn_mfma_f32_16x16x32_bf16(fa, fb, a, 0, 0, 0); }
            const int i = 16 * it + (lane & 15), j0 = 16 * jt + 4 * (lane >> 4); float o[4];
#pragma unroll
            for (int q = 0; q < 4; ++q) o[q] = (d ? (j0 + q >= i) : (j0 + q <= i)) ? a[q] : 0.f;
            u32x2 wv; wv.x = pk2(o[0], o[1]); wv.y = pk2(o[2], o[3]); *(u32x2*)(ob + GL_ATT + (size_t)(i * 64 + j0) * 2) = wv; }
        if (w < 6) { const int ta = w < 3 ? 0 : w < 5 ? 1 : 2, tb = w < 3 ? w + 1 : w < 5 ? w - 1 : 3; const int it = d ? tb : ta, jt = d ? ta : tb;
            const int i = 16 * it + (lane & 15), j0 = 16 * jt + 4 * (lane >> 4); const u32x2 z = {0u, 0u}; *(u32x2*)(ob + GL_ATT + (size_t)(i * 64 + j0) * 2) = z; }
#pragma unroll
        for (int j = 0; j < 4; ++j) { const int cidx = F.tid + 512 * j; { const int pos = cidx >> 5, cc = cidx & 31; *(u32x4*)(ob + GL_QIN + (size_t)(pos * 256 + cc * 8) * 2) = *(const u32x4*)(qL + pos * 264 + cc * 8); }
            { const int rr = cidx >> 3, cc = cidx & 7; *(u32x4*)(ob + GL_KDT + (size_t)(rr * 64 + cc * 8) * 2) = *(const u32x4*)(kdT + rr * 72 + cc * 8); } }
        WG_BAR();
    }
}
constexpr int GL_LQI = 33792, GL_LKD = 67584, GL_LAT = 104448, GL_LVT = 113664, GL_LGL = 122880, GL_OB = 123904, GL_OBP = 72;
struct GlStage { u32x4 qi[4], kd[4], at, vt, gl; };
__device__ __forceinline__ void gla_stage_load(GlStage& st, const unsigned char* ib, const unsigned char* iv, int sl, int tid) {
    const unsigned o = (unsigned)tid * 16u;
#pragma unroll
    for (int j = 0; j < 4; ++j) { st.qi[j] = *(const u32x4*)(ib + GL_QIN + 8192 * j + o); st.kd[j] = *(const u32x4*)(ib + GL_KDT + 8192 * j + o); }
    st.at = *(const u32x4*)(ib + GL_ATT + o);
    st.vt = *(const u32x4*)(iv + 8192 * sl + o);
    st.gl = *(const u32x4*)(ib + GL_GL + (o & 1023u));
}
__device__ __forceinline__ void gla_stage_store(const GlStage& st, unsigned char* lds, int tid) {
#pragma unroll
    for (int j = 0; j < 4; ++j) { const int cidx = tid + 512 * j; *(u32x4*)(lds + GL_LQI + (cidx >> 5) * 528 + (cidx & 31) * 16) = st.qi[j]; *(u32x4*)(lds + GL_LKD + (cidx >> 3) * 144 + (cidx & 7) * 16) = st.kd[j]; }
    *(u32x4*)(lds + GL_LAT + (tid >> 3) * 144 + (tid & 7) * 16) = st.at;
    *(u32x4*)(lds + GL_LVT + (tid >> 3) * 144 + (tid & 7) * 16) = st.vt;
    if (tid < 64) *(u32x4*)(lds + GL_LGL + tid * 16) = st.gl;
}
__device__ __forceinline__ int gla_chunk(int d, int t) { return d ? (t < 4 ? 3 - t : 71 - t) : t; }
__device__ __forceinline__ void gla_flush(Frame& F, int tlast, int b, int d, int h, int sl) {
    const bf16_t* Ob = (const bf16_t*)(F.ldsg + GL_OB); bf16_t* O = (bf16_t*)(F.ws + WS_OGL);
#pragma unroll
    for (int j = 0; j < 2; ++j) { const int idx = F.tid + 512 * j, c8 = idx & 7, pos = (idx >> 3) & 63, sn = idx >> 9;
        const u32x4 v = *(const u32x4*)(Ob + (sn * 64 + pos) * GL_OBP + 8 * c8); const int r = chunk_row0(b, gla_chunk(d, tlast - 1 + sn)) + pos;
        *(u32x4*)(O + ((size_t)d * NL + r) * D + h * 512 + 64 * sl + 8 * c8) = v; }
}
__device__ __forceinline__ void p14_gla_scan(Frame& F) {
    unsigned char* L = F.ldsg; bf16_t* St = (bf16_t*)L; bf16_t* Ob = (bf16_t*)(L + GL_OB);
    const int w = F.wave, lr = F.lane & 15, lq = F.lane >> 4, pt = w >> 1, cth = w & 1;
    for (int unit0 = F.bid; unit0 < 256; unit0 += F.G) {
        const int unit = (unit0 & 7) * 32 + (unit0 >> 3);
        const int sl = unit & 7, chain = unit >> 3, d = chain & 1, h = (chain >> 1) & 3, b = chain >> 3;
        f32x4 accS[4][2];
#pragma unroll
        for (int a = 0; a < 4; ++a)
#pragma unroll
            for (int c2 = 0; c2 < 2; ++c2) accS[a][c2] = (f32x4){0.f, 0.f, 0.f, 0.f};
        for (int i = F.tid; i < 33792 / 4; i += 512) ((unsigned*)L)[i] = 0u;
        const unsigned char* gb0 = F.ws + WS_GLB + (size_t)(chain * NCH) * GL_STRIDE; const unsigned char* gv0 = F.ws + WS_GLV + (size_t)((chain >> 1) * NCH) * GLV_STRIDE;
        GlStage sgA, sgB;
        { const int n0 = gla_chunk(d, 0), n1 = gla_chunk(d, 1); gla_stage_load(sgA, gb0 + (size_t)n0 * GL_STRIDE, gv0 + (size_t)n0 * GLV_STRIDE, sl, F.tid); gla_stage_load(sgB, gb0 + (size_t)n1 * GL_STRIDE, gv0 + (size_t)n1 * GLV_STRIDE, sl, F.tid); }
#pragma unroll 1
        for (int t = 0; t < NCH; t += 2) {
            {
            gla_stage_store(sgA, L, F.tid);
            if (t >= 6 && (t & 1) == 0) gla_flush(F, t - 1, b, d, h, sl);
            { const int n1 = gla_chunk(d, t + 2 < NCH ? t + 2 : NCH - 1); gla_stage_load(sgA, gb0 + (size_t)n1 * GL_STRIDE, gv0 + (size_t)n1 * GLV_STRIDE, sl, F.tid); }
            WG_BAR();
            if (t >= 4) {
                f32x4 ao[2] = {{0.f, 0.f, 0.f, 0.f}, {0.f, 0.f, 0.f, 0.f}};
#pragma unroll
                for (int kk = 0; kk < 8; ++kk) { const bf16x8 fq = *(const bf16x8*)(L + GL_LQI + (16 * pt + lr) * 528 + 64 * kk + 16 * lq);
#pragma unroll
                    for (int c2 = 0; c2 < 2; ++c2) { const bf16x8 fs = *(const bf16x8*)(St + (16 * (2 * cth + c2) + lr) * 264 + 32 * kk + 8 * lq); ao[c2] = __builtin_amdgcn_mfma_f32_16x16x32_bf16(fq, fs, ao[c2], 0, 0, 0); } }
#pragma unroll
                for (int kk = 0; kk < 2; ++kk) { const bf16x8 fa = *(const bf16x8*)(L + GL_LAT + (16 * pt + lr) * 144 + 64 * kk + 16 * lq);
#pragma unroll
                    for (int c2 = 0; c2 < 2; ++c2) { const bf16x8 fv = *(const bf16x8*)(L + GL_LVT + (16 * (2 * cth + c2) + lr) * 144 + 64 * kk + 16 * lq); ao[c2] = __builtin_amdgcn_mfma_f32_16x16x32_bf16(fa, fv, ao[c2], 0, 0, 0); } }
#pragma unroll
                for (int c2 = 0; c2 < 2; ++c2)
#pragma unroll
                    for (int q = 0; q < 4; ++q) Ob[((t & 1) * 64 + 16 * pt + 4 * lq + q) * GL_OBP + 16 * (2 * cth + c2) + lr] = (bf16_t)f2bf(ao[c2][q]);
            }
            WG_BAR();
            bf16x8 fv[2][2];
#pragma unroll
            for (int c2 = 0; c2 < 2; ++c2)
#pragma unroll
                for (int kk = 0; kk < 2; ++kk) fv[c2][kk] = *(const bf16x8*)(L + GL_LVT + (16 * (2 * cth + c2) + lr) * 144 + 64 * kk + 16 * lq);
#pragma unroll
            for (int a = 0; a < 4; ++a) { const int rt = 4 * pt + a; const f32x4 gl = *(const f32x4*)(L + GL_LGL + (16 * rt + 4 * lq) * 4);
                bf16x8 fk[2];
#pragma unroll
                for (int kk = 0; kk < 2; ++kk) fk[kk] = *(const bf16x8*)(L + GL_LKD + (16 * rt + lr) * 144 + 64 * kk + 16 * lq);
#pragma unroll
                for (int c2 = 0; c2 < 2; ++c2) { accS[a][c2] = accS[a][c2] * gl;
#pragma unroll
                    for (int kk = 0; kk < 2; ++kk) accS[a][c2] = __builtin_amdgcn_mfma_f32_16x16x32_bf16(fk[kk], fv[c2][kk], accS[a][c2], 0, 0, 0);
                    u32x2 sv; sv.x = pk2(accS[a][c2][0], accS[a][c2][1]); sv.y = pk2(accS[a][c2][2], accS[a][c2][3]); *(u32x2*)(St + (16 * (2 * cth + c2) + lr) * 264 + 16 * rt + 4 * lq) = sv; } }
            WG_BAR();
                    }
            {
            gla_stage_store(sgB, L, F.tid);
            if ((t + 1) >= 6 && ((t + 1) & 1) == 0) gla_flush(F, (t + 1) - 1, b, d, h, sl);
            { const int n1 = gla_chunk(d, (t + 1) + 2 < NCH ? (t + 1) + 2 : NCH - 1); gla_stage_load(sgB, gb0 + (size_t)n1 * GL_STRIDE, gv0 + (size_t)n1 * GLV_STRIDE, sl, F.tid); }
            WG_BAR();
            if ((t + 1) >= 4) {
                f32x4 ao[2] = {{0.f, 0.f, 0.f, 0.f}, {0.f, 0.f, 0.f, 0.f}};
#pragma unroll
                for (int kk = 0; kk < 8; ++kk) { const bf16x8 fq = *(const bf16x8*)(L + GL_LQI + (16 * pt + lr) * 528 + 64 * kk + 16 * lq);
#pragma unroll
                    for (int c2 = 0; c2 < 2; ++c2) { const bf16x8 fs = *(const bf16x8*)(St + (16 * (2 * cth + c2) + lr) * 264 + 32 * kk + 8 * lq); ao[c2] = __builtin_amdgcn_mfma_f32_16x16x32_bf16(fq, fs, ao[c2], 0, 0, 0); } }
#pragma unroll
                for (int kk = 0; kk < 2; ++kk) { const bf16x8 fa = *(const bf16x8*)(L + GL_LAT + (16 * pt + lr) * 144 + 64 * kk + 16 * lq);
#pragma unroll
                    for (int c2 = 0; c2 < 2; ++c2) { const bf16x8 fv = *(const bf16x8*)(L + GL_LVT + (16 * (2 * cth + c2) + lr) * 144 + 64 * kk + 16 * lq); ao[c2] = __builtin_amdgcn_mfma_f32_16x16x32_bf16(fa, fv, ao[c2], 0, 0, 0); } }
#pragma unroll
                for (int c2 = 0; c2 < 2; ++c2)
#pragma unroll
                    for (int q = 0; q < 4; ++q) Ob[(((t + 1) & 1) * 64 + 16 * pt + 4 * lq + q) * GL_OBP + 16 * (2 * cth + c2) + lr] = (bf16_t)f2bf(ao[c2][q]);
            }
            WG_BAR();
            bf16x8 fv[2][2];
#pragma unroll
            for (int c2 = 0; c2 < 2; ++c2)
#pragma unroll
                for (int kk = 0; kk < 2; ++kk) fv[c2][kk] = *(const bf16x8*)(L + GL_LVT + (16 * (2 * cth + c2) + lr) * 144 + 64 * kk + 16 * lq);
#pragma unroll
            for (int a = 0; a < 4; ++a) { const int rt = 4 * pt + a; const f32x4 gl = *(const f32x4*)(L + GL_LGL + (16 * rt + 4 * lq) * 4);
                bf16x8 fk[2];
#pragma unroll
                for (int kk = 0; kk < 2; ++kk) fk[kk] = *(const bf16x8*)(L + GL_LKD + (16 * rt + lr) * 144 + 64 * kk + 16 * lq);
#pragma unroll
                for (int c2 = 0; c2 < 2; ++c2) { accS[a][c2] = accS[a][c2] * gl;
#pragma unroll
                    for (int kk = 0; kk < 2; ++kk) accS[a][c2] = __builtin_amdgcn_mfma_f32_16x16x32_bf16(fk[kk], fv[c2][kk], accS[a][c2], 0, 0, 0);
                    u32x2 sv; sv.x = pk2(accS[a][c2][0], accS[a][c2][1]); sv.y = pk2(accS[a][c2][2], accS[a][c2][3]); *(u32x2*)(St + (16 * (2 * cth + c2) + lr) * 264 + 16 * rt + 4 * lq) = sv; } }
            WG_BAR();
                    }
        }
        gla_flush(F, NCH - 1, b, d, h, sl);
        WG_BAR();
    }
}
__device__ __forceinline__ void p15_gla_post(Frame& F) {
    const int gw = F.bid * NWAVES + F.wave, NGW = F.G * NWAVES;
    const int r_beg = (int)(((long long)gw * NL) / NGW), r_end = (int)(((long long)(gw + 1) * NL) / NGW);
    const bf16_t* O = (const bf16_t*)(F.ws + WS_OGL); const bf16_t* P = (const bf16_t*)(F.ws + WS_P); bf16_t* A1 = (bf16_t*)(F.ws + WS_A1B); const float* nw = F.ap->in[I_GLANORM];
    int c8 = 8 * F.lane; asm volatile("" : "+v"(c8));
    float nwr[8];
#pragma unroll
    for (int q = 0; q < 8; ++q) nwr[q] = nw[c8 + q];
    u32x4 a[4], bq[4], rv[4], an[4], bn[4], rn[4];
    if (r_beg < r_end) {
#pragma unroll
        for (int j = 0; j < 4; ++j) { a[j] = *(const u32x4*)(O + (size_t)r_beg * D + 512 * j + c8); bq[j] = *(const u32x4*)(O + ((size_t)NL + r_beg) * D + 512 * j + c8); rv[j] = *(const u32x4*)(P + (size_t)r_beg * EINP + 4096 + 512 * j + c8); }
    }
#pragma unroll 1
    for (int r = r_beg; r < r_end; ++r) {
        { const int rn_ = r + 1 < r_end ? r + 1 : r;
#pragma unroll
          for (int j = 0; j < 4; ++j) { an[j] = *(const u32x4*)(O + (size_t)rn_ * D + 512 * j + c8); bn[j] = *(const u32x4*)(O + ((size_t)NL + rn_) * D + 512 * j + c8); rn[j] = *(const u32x4*)(P + (size_t)rn_ * EINP + 4096 + 512 * j + c8); } }
        float o[32], ss[4];
#pragma unroll
        for (int j = 0; j < 4; ++j) {
            o[8 * j + 0] = bflo(a[j].x) + bflo(bq[j].x); o[8 * j + 1] = bfhi(a[j].x) + bfhi(bq[j].x); o[8 * j + 2] = bflo(a[j].y) + bflo(bq[j].y); o[8 * j + 3] = bfhi(a[j].y) + bfhi(bq[j].y);
            o[8 * j + 4] = bflo(a[j].z) + bflo(bq[j].z); o[8 * j + 5] = bfhi(a[j].z) + bfhi(bq[j].z); o[8 * j + 6] = bflo(a[j].w) + bflo(bq[j].w); o[8 * j + 7] = bfhi(a[j].w) + bfhi(bq[j].w);
            float t = 0.f;
#pragma unroll
            for (int q = 0; q < 8; ++q) t += o[8 * j + q] * o[8 * j + q];
            ss[j] = t; }
#pragma unroll
        for (int j = 0; j < 4; ++j) ss[j] = wave_sum(ss[j]);
#pragma unroll
        for (int j = 0; j < 4; ++j) { const float rstd = 1.0f / sqrtf(ss[j] * (1.f / 512.f) + EPS); float g8[8];
            g8[0] = bflo(rv[j].x); g8[1] = bfhi(rv[j].x); g8[2] = bflo(rv[j].y); g8[3] = bfhi(rv[j].y); g8[4] = bflo(rv[j].z); g8[5] = bfhi(rv[j].z); g8[6] = bflo(rv[j].w); g8[7] = bfhi(rv[j].w);
            float y[8];
#pragma unroll
            for (int q = 0; q < 8; ++q) y[q] = o[8 * j + q] * rstd * nwr[q] * siluf_(g8[q]);
            u32x4 wv; wv.x = pk2(y[0], y[1]); wv.y = pk2(y[2], y[3]); wv.z = pk2(y[4], y[5]); wv.w = pk2(y[6], y[7]); *(u32x4*)(A1 + (size_t)r * D + 512 * j + c8) = wv; }
#pragma unroll
        for (int j = 0; j < 4; ++j) { a[j] = an[j]; bq[j] = bn[j]; rv[j] = rn[j]; }
    }
}

__device__ __forceinline__ void p17_ln_router(Frame& F) {
    const float* MOD = (const float*)(F.ws + WS_MOD) + (size_t)5 * NMOD; const float* XR = (const float*)(F.ws + WS_XR); bf16_t* A2 = (bf16_t*)(F.ws + WS_A2B);
    const float* lg = F.ap->in[I_LN1G] + D; const float* lb = F.ap->in[I_LN1B] + D; const float* wrt = (const float*)(F.ws + MOE_RT);
    int* hist = (int*)F.ldsg; float* RTL = (float*)(F.ldsg + 1024);
    for (int i = F.tid; i < 8 * 2048 / 4; i += 512) *(f32x4*)(RTL + 4 * i) = *(const f32x4*)(wrt + 4 * i);
    int l4 = 4 * F.lane; asm volatile("" : "+v"(l4));
    for (int rb = F.bid; rb < 256; rb += F.G) {
        if (F.tid < 8) hist[F.tid] = 0;
        __syncthreads();
        const float* md = MOD + (size_t)(rb >> 6) * NMOD;
        f32x4 P[8], Q[8], v[8], vn[8]; ln_pq(lg, lb, md + 3 * 2048, md + 4 * 2048, l4, P, Q);
        const int r0 = rb * 64 + F.wave * 8;
#pragma unroll
        for (int j = 0; j < 8; ++j) v[j] = *(const f32x4*)(XR + (size_t)r0 * D + l4 + 256 * j);
#pragma unroll 1
        for (int q = 0; q < 8; ++q) {
            const int r = r0 + q;
            { const float* xn = XR + (size_t)(r0 + (q < 7 ? q + 1 : q)) * D;
#pragma unroll
              for (int j = 0; j < 8; ++j) vn[j] = *(const f32x4*)(xn + l4 + 256 * j); }
            float mean, rstd; row_stats(v, mean, rstd);
            float lg8[8];
#pragma unroll
            for (int e = 0; e < 8; ++e) lg8[e] = 0.f;
#pragma unroll
            for (int j = 0; j < 8; ++j) { const f32x4 t = (v[j] - mean) * rstd * P[j] + Q[j];
                u32x2 w; w.x = pk2(t[0], t[1]); w.y = pk2(t[2], t[3]); *(u32x2*)(A2 + (size_t)r * D + l4 + 256 * j) = w;
#pragma unroll
                for (int e = 0; e < 8; ++e) { const f32x4 we = *(const f32x4*)(RTL + e * D + l4 + 256 * j); lg8[e] += (t[0] * we[0] + t[1] * we[1]) + (t[2] * we[2] + t[3] * we[3]); } }
#pragma unroll
            for (int e = 0; e < 8; ++e) lg8[e] = wave_sum(lg8[e]);
            int e0 = 0; float l0 = lg8[0];
#pragma unroll
            for (int e = 1; e < 8; ++e) if (lg8[e] > l0) { l0 = lg8[e]; e0 = e; }
            int e1 = -1; float l1 = -3.0e38f;
#pragma unroll
            for (int e = 0; e < 8; ++e) if (e != e0 && lg8[e] > l1) { l1 = lg8[e]; e1 = e; }
            if (e1 < 0) { e1 = (e0 + 1) & 7; l1 = l0; }
            const float ex = __expf(l1 - l0); const float g0 = 1.0f / (1.0f + ex), g1 = ex / (1.0f + ex);
            if (F.lane == 0) { *(f32x2*)((float*)(F.ws + MOE_STATS) + (size_t)r * 2) = (f32x2){mean, rstd}; int* tk = (int*)(F.ws + MOE_TOPK) + (size_t)r * 4; tk[0] = e0; tk[1] = e1; ((float*)tk)[2] = g0; ((float*)tk)[3] = g1; atomicAdd(&hist[e0], 1); atomicAdd(&hist[e1], 1); }
#pragma unroll
            for (int j = 0; j < 8; ++j) v[j] = vn[j];
        }
        __syncthreads();
        if (F.tid < 8) ((int*)(F.ws + MOE_HIST))[rb * 8 + F.tid] = hist[F.tid];
        __syncthreads();
    }
}
__device__ __forceinline__ void p18_moe_place(Frame& F) {
    int* sm = (int*)F.ldsg;
    const int* HIST = (const int*)(F.ws + MOE_HIST); const int* TOPK = (const int*)(F.ws + MOE_TOPK); int* DEST = (int*)(F.ws + MOE_DEST); int* TBL = (int*)(F.ws + MOE_TBL);
    const bf16_t* A2 = (const bf16_t*)(F.ws + WS_A2B); bf16_t* XG = (bf16_t*)(F.ws + WS_XG);
    for (int rb = F.bid; rb < 256; rb += F.G) {
        u32x4 v[8][4];
#pragma unroll
        for (int q = 0; q < 8; ++q)
#pragma unroll
            for (int j = 0; j < 4; ++j) v[q][j] = *(const u32x4*)(A2 + (size_t)(rb * 64 + F.wave * 8 + q) * D + 8 * F.lane + 512 * j);
        if (F.tid < 16) sm[F.tid] = 0;
        __syncthreads();
        {
            const int q = F.tid >> 1; const u32x4 hv = *(const u32x4*)(HIST + q * 8 + 4 * (F.tid & 1));
            int t4[4] = {(int)hv.x, (int)hv.y, (int)hv.z, (int)hv.w}, b4[4];
#pragma unroll
            for (int i = 0; i < 4; ++i) b4[i] = q < rb ? t4[i] : 0;
#pragma unroll
            for (int o = 2; o < 64; o <<= 1)
#pragma unroll
                for (int i = 0; i < 4; ++i) { t4[i] += __shfl_xor(t4[i], o); b4[i] += __shfl_xor(b4[i], o); }
            if (F.lane < 2) {
#pragma unroll
                for (int i = 0; i < 4; ++i) { atomicAdd(&sm[4 * F.lane + i], t4[i]); atomicAdd(&sm[8 + 4 * F.lane + i], b4[i]); } }
        }
        __syncthreads();
        if (F.tid == 0) { int ps = 0; for (int e = 0; e < 8; ++e) { sm[24 + e] = ps; sm[16 + e] = ps + sm[8 + e]; ps += (sm[e] + 255) / 256 * 256; }
            if (rb == 0) { int p = 0; for (int e = 0; e < 8; ++e) { const int np = (sm[e] + 255) / 256; for (int q = 0; q < np; ++q) TBL[p++] = e; } TBL[159] = p; } }
        __syncthreads();
        if (F.wave == 0) { const int r = rb * 64 + F.lane; const int e0 = TOPK[r * 4], e1 = TOPK[r * 4 + 1]; int d0 = 0, d1 = 0;
            const unsigned long long lt = (1ull << F.lane) - 1ull;
#pragma unroll
            for (int e = 0; e < 8; ++e) { const unsigned long long m0 = __ballot(e0 == e), m1 = __ballot(e1 == e);
                if (e0 == e) d0 = sm[16 + e] + __popcll(m0 & lt); if (e1 == e) d1 = sm[16 + e] + __popcll(m0) + __popcll(m1 & lt); }
            DEST[r * 2] = d0; DEST[r * 2 + 1] = d1; sm[32 + 2 * F.lane] = d0; sm[32 + 2 * F.lane + 1] = d1; }
        __syncthreads();
#pragma unroll
        for (int q = 0; q < 8; ++q) { const int tl = F.wave * 8 + q; const int d0 = sm[32 + 2 * tl], d1 = sm[32 + 2 * tl + 1];
#pragma unroll
            for (int j = 0; j < 4; ++j) { *(u32x4*)(XG + (size_t)d0 * D + 8 * F.lane + 512 * j) = v[q][j]; *(u32x4*)(XG + (size_t)d1 * D + 8 * F.lane + 512 * j) = v[q][j]; } }
        __syncthreads();
    }
}
__device__ __forceinline__ void p21_final(Frame& F) {
    const int gw = F.bid * NWAVES + F.wave, NGW = F.G * NWAVES;
    const float* MOD = (const float*)(F.ws + WS_MOD) + (size_t)5 * NMOD; const float* XR = (const float*)(F.ws + WS_XR); const bf16_t* YG = (const bf16_t*)(F.ws + WS_YG);
    const int* TOPK = (const int*)(F.ws + MOE_TOPK); const int* DEST = (const int*)(F.ws + MOE_DEST); const float* lg = F.ap->in[I_LN2G] + D; const float* lb = F.ap->in[I_LN2B] + D;
    int l4 = 4 * F.lane; asm volatile("" : "+v"(l4));
    f32x4 LG[8], LB[8];
#pragma unroll
    for (int j = 0; j < 8; ++j) { LG[j] = *(const f32x4*)(lg + l4 + 256 * j); LB[j] = *(const f32x4*)(lb + l4 + 256 * j); }
#pragma unroll 1
    for (int r = gw; r < NL; r += NGW) {
        const float g0 = ((const float*)TOPK)[r * 4 + 2], g1 = ((const float*)TOPK)[r * 4 + 3]; const int d0 = DEST[r * 2], d1 = DEST[r * 2 + 1]; const float* md = MOD + (size_t)(r >> 12) * NMOD + 5 * 2048;
        f32x4 v[8];
        const f32x2 st3 = *(const f32x2*)((const float*)(F.ws + MOE_STATS) + (size_t)r * 2); const float* lg1 = F.ap->in[I_LN1G] + D; const float* lb1 = F.ap->in[I_LN1B] + D;
#pragma unroll
        for (int j = 0; j < 8; ++j) { const int c = l4 + 256 * j; const f32x4 x = (*(const f32x4*)(XR + (size_t)r * D + c) - st3.x) * st3.y * *(const f32x4*)(lg1 + c) + *(const f32x4*)(lb1 + c), gt = *(const f32x4*)(md + c);
            const u32x2 a0 = *(const u32x2*)(YG + (size_t)d0 * D + c), a1 = *(const u32x2*)(YG + (size_t)d1 * D + c);
            const f32x4 y0 = {bflo(a0.x), bfhi(a0.x), bflo(a0.y), bfhi(a0.y)}, y1 = {bflo(a1.x), bfhi(a1.x), bflo(a1.y), bfhi(a1.y)};
            v[j] = x * ALPHA + gt * (y0 * g0 + y1 * g1); }
        float mean, rstd; row_stats(v, mean, rstd);
#pragma unroll
        for (int j = 0; j < 8; ++j) { const int c = l4 + 256 * j; *(f32x4*)(F.out + (size_t)r * D + c) = (v[j] - mean) * rstd * LG[j] + LB[j]; }
    }
}


__device__ __forceinline__ void combine_tail(Frame& F, const float* PART, int U, int S, int pm0, int nN, float* Y, int mode, const float* res, size_t res_row0, const float* gate) {
    const size_t nvec = (size_t)U * 16384;
    for (size_t v = (size_t)F.bid * 512 + F.tid; v < nvec; v += (size_t)F.G * 512) {
        const int u = (int)(v >> 14), rem = (int)(v & 16383), r = rem >> 6, c4 = rem & 63;
        f32x4 sum = {0.f, 0.f, 0.f, 0.f};
        for (int sx = 0; sx < S; ++sx) sum += *(const f32x4*)(PART + ((size_t)(u * S + sx) * 256 + r) * 256 + 4 * c4);
        const size_t row = (size_t)(pm0 + u / nN) * 256 + r; const int col = (u % nN) * 256 + 4 * c4;
        if (mode == 2) { u32x2 w; w.x = pk2(sum[0], sum[1]); w.y = pk2(sum[2], sum[3]); *(u32x2*)((bf16_t*)Y + row * D + col) = w; continue; }
        if (mode == 1) { const f32x4 rv = *(const f32x4*)(res + (row - res_row0) * D + col), gv = *(const f32x4*)(gate + col); sum = rv * ALPHA + gv * sum; }
        if (mode == 3) { const f32x2 st = *(const f32x2*)((const float*)(F.ws + MOE_STATS) + row * 2); const f32x4 rv = (*(const f32x4*)(res + (row - res_row0) * D + col) - st.x) * st.y * *(const f32x4*)(F.ap->in[I_LN1G] + col) + *(const f32x4*)(F.ap->in[I_LN1B] + col);
            sum = rv * ALPHA + *(const f32x4*)(gate + col) * sum; }
        *(f32x4*)(Y + row * D + col) = sum;
    }
}
constexpr int N_PHASES = 25;
__global__ void __launch_bounds__(NWAVES * 64, 2) fwd_kernel(Args args) {
    extern __shared__ __attribute__((aligned(16))) unsigned char lds[];
    Frame F;
    F.lds = (LAS unsigned char*)lds; F.ldsg = lds;
    F.tid = threadIdx.x; F.lane = F.tid & 63; F.wave = __builtin_amdgcn_readfirstlane(F.tid >> 6);
    F.G = gridDim.x; F.bid = blockIdx.x; F.out = args.out; F.ws = args.ws; F.ap = &args;
    volatile LAS unsigned* MISC = (volatile LAS unsigned*)(F.lds + MISC_OFF);
    if (F.tid < 32) MISC[F.tid] = 0u;
    __syncthreads();
    XcdBarrier bar; bar.bar = (unsigned*)(F.ws + WS_CTL) + CW_BAR; bar.x = 0; bar.st = nullptr;
    const bool one_launch = (args.ph_hi - args.ph_lo) > 1;
    if (one_launch) bar = xcd_barrier_post((unsigned*)(F.ws + WS_CTL) + CW_BAR, MISC + 8);
    const int lo = args.ph_lo, hi = args.ph_hi;
#ifndef PHASE_MASK
#define PHASE_MASK 0xFFFFFFFFu
#endif
#define IN(k) (((PHASE_MASK >> (k)) & 1u) && lo <= (k) && (k) < hi)
#define SEAM(k) do { if (IN(k) && IN((k) + 1)) xcd_barrier(bar); } while (0)
#ifndef PROBE_REP
#define PROBE_REP 0u
#endif
#define PH(k, ...) if (IN(k)) { __VA_ARGS__ if ((PROBE_REP >> (k)) & 1u) { xcd_barrier(bar); __VA_ARGS__ } } SEAM(k);
    unsigned char* ws = F.ws;
    const float* MOD = (const float*)(ws + WS_MOD);

    PH(0, p0_prologue(F);)
    PH(1, p1_modulate(F);)
    PH(2,
        pg8::Gemm g{D, D, D}; pg8::SchedDense S; S.init(ws + WS_A0, ws + WS_WIN0, D, D, MT / 256, EINP / 256, F.G, F.bid);
        pg8::EpiP0 E{(bf16_t*)(ws + WS_P), (bf16_t*)(ws + WS_AS5)};
        pg8::gemm_phase(F.lds, g, S, E);
        if (F.G == 256) tail_convert(F, TB2, TQ2, (int)F.bid - 164);)
    PH(3,
        p3_dn_conv(F);
        __syncthreads();
        pg8::Gemm g{512, 256, 256}; pg8::SchedGroup S; S.init(ws + WS_AS5, ws + WS_S5W, 512, 256, (size_t)256 * 256 * 2, nullptr, 5, 320, 1, F.G, F.bid);
        pg8::EpiF32 E{(float*)(ws + WS_E), 256};
        pg8::gemm_phase(F.lds, g, S, E);)
    PH(4, p4_s5_scan(F); __syncthreads(); p4_dn_prep(F);)
    PH(5,
        const bool split = (F.G == 256); const int gG = split ? 128 : F.G, gC = split ? F.bid - 128 : F.bid;
        if (!split || F.bid >= 128) { pg8::Gemm g{512, 512, 512}; pg8::SchedGroup S; S.init(ws + WS_AS5, ws + WS_S5M, 512, 512, (size_t)256 * 512 * 2, nullptr, 5, 320, 1, gG, gC);
          pg8::EpiS5C E{(const bf16_t*)(ws + WS_P), (bf16_t*)(ws + WS_A1), F.ap->in[I_S5D]};
          pg8::gemm_phase(F.lds, g, S, E); }
        __syncthreads();
        if (!split || F.bid < 128) p5_dn_scan(F, split ? 128 : F.G, F.bid);)
    PH(6, p6_dn_post(F);)
    PH(7,
        { pg8::Gemm g{D, D, D}; pg8::SchedDense S; S.init(ws + WS_A1, ws + WS_WOUT0, D, D, NL / 256, D / 256, F.G, F.bid);
          pg8::EpiYT<false> E{F.ap->in[I_X], F.ap->in[I_CTX], (float*)(ws + WS_XR), MOD + 2 * 2048, nullptr, nullptr, nullptr};
          pg8::gemm_phase(F.lds, g, S, E); }
        { pg8::Gemm g{D, D, 256}; pg8::SchedSplit S; S.init(ws + WS_A1, ws + WS_WOUT0, D, D, 0, nullptr, NL / 256, D / 256, 32, 8, 256, F.G, F.bid);
          pg8::EpiF32 E{(float*)(ws + WS_P), 256};
          pg8::gemm_phase(F.lds, g, S, E); })
    PH(8, combine_tail(F, (const float*)(ws + WS_P), 32, 8, NL / 256, D / 256, (float*)(ws + WS_XR), 1, F.ap->in[I_CTX], NL, MOD + 2 * 2048 + (size_t)4 * NMOD);)
    PH(9, ln_mod_rows(F, MT, F.ap->in[I_LN1G], F.ap->in[I_LN1B], 0, 3, 4, (bf16_t*)(ws + WS_A0));)
    PH(10,
        pg8::Gemm g{D, D, D}; pg8::SchedDense S; S.init(ws + WS_A0, ws + WS_W130, D, D, MT / 256, 2 * FFH / 256, F.G, F.bid);
        pg8::EpiH E{(bf16_t*)(ws + WS_H0), FFH};
        pg8::gemm_phase(F.lds, g, S, E);
        if (F.G == 256) tail_convert(F, TB9, TQ9, (int)F.bid - 176);)
    PH(11,
        const float* xr = (const float*)(ws + WS_XR);
        { pg8::Gemm g{FFH, FFH, FFH}; pg8::SchedDense S; S.init(ws + WS_H0, ws + WS_W20, FFH, FFH, NL / 256, D / 256, F.G, F.bid);
          pg8::EpiYT<true> E{xr, xr + (size_t)NL * D, (float*)(ws + WS_XR), MOD + 5 * 2048, (const float*)(ws + MOE_STATS), F.ap->in[I_LN1G], F.ap->in[I_LN1B]};
          pg8::gemm_phase(F.lds, g, S, E); }
        { pg8::Gemm g{FFH, FFH, 1408}; pg8::SchedSplit S; S.init(ws + WS_H0, ws + WS_W20, FFH, FFH, 0, nullptr, NL / 256, D / 256, 32, 4, 1408, F.G, F.bid);
          pg8::EpiF32 E{(float*)(ws + WS_P), 256};
          pg8::gemm_phase(F.lds, g, S, E); }
        if (F.G == 256) tail_convert(F, TB10, TQ10, (int)F.bid - 128);)
    PH(12, combine_tail(F, (const float*)(ws + WS_P), 32, 4, NL / 256, D / 256, (float*)(ws + WS_XR), 3, (const float*)(ws + WS_XR), 0, MOD + 5 * 2048 + (size_t)4 * NMOD);)
    PH(13, ln_mod_rows(F, MT, F.ap->in[I_LN2G], F.ap->in[I_LN2B], 1, 0, 1, (bf16_t*)(ws + WS_A0));)
    PH(14,
        pg8::Gemm g{D, D, D}; pg8::SchedDense S; S.init(ws + WS_A0, ws + WS_WIN1, D, D, MT / 256, EINP / 256, F.G, F.bid);
        pg8::EpiBf E{(bf16_t*)(ws + WS_P), EINP};
        pg8::gemm_phase(F.lds, g, S, E);
        if (F.G == 256) tail_convert(F, TB12, TQ12, (int)F.bid - 164);)
    PH(15, p13_gla_prep(F);)
    PH(16, p14_gla_scan(F);)
    PH(17, p15_gla_post(F);)
    PH(18,
        pg8::Gemm g{D, D, D}; pg8::SchedDense S; S.init(ws + WS_A1B, ws + WS_WOUT1, D, D, NL / 256, D / 256, F.G, F.bid);
        const float* xr = (const float*)(ws + WS_XR);
        pg8::EpiYT<true> E{xr, xr + (size_t)NL * D, (float*)(ws + WS_XR), MOD + (size_t)5 * NMOD + 2 * 2048, (const float*)(ws + MOE_STATS), F.ap->in[I_LN2G], F.ap->in[I_LN2B]};
        pg8::gemm_phase(F.lds, g, S, E);)
    PH(19, p17_ln_router(F);)
    PH(20, p18_moe_place(F);)
    PH(21,
        const int* TBL = (const int*)(ws + MOE_TBL); int nP = TBL[159]; nP = nP < 0 ? 0 : (nP > MOE_MAXP ? MOE_MAXP : nP);
        pg8::Gemm g{D, D, D}; pg8::SchedGroup S; S.init(ws + WS_XG, ws + WS_W13M, D, D, (size_t)2 * EXH * D * 2, TBL, 1, nP, 2 * EXH / 256, F.G, F.bid);
        pg8::EpiH E{(bf16_t*)(ws + WS_HM), EXH};
        pg8::gemm_phase(F.lds, g, S, E);)
    PH(22,
        const int* TBL = (const int*)(ws + MOE_TBL); int nP = TBL[159]; nP = nP < 0 ? 0 : (nP > MOE_MAXP ? MOE_MAXP : nP);
        { pg8::Gemm g{EXH, EXH, EXH}; pg8::SchedGroup S; S.init(ws + WS_HM, ws + WS_W2M, EXH, EXH, (size_t)D * EXH * 2, TBL, 1, 128, D / 256, F.G, F.bid);
          pg8::EpiBf E{(bf16_t*)(ws + WS_YG), D};
          pg8::gemm_phase(F.lds, g, S, E); }
        if (nP > 128) { pg8::Gemm g{EXH, EXH, 896}; pg8::SchedSplit S; S.init(ws + WS_HM, ws + WS_W2M, EXH, EXH, (size_t)D * EXH * 2, TBL, 128, D / 256, (nP - 128) * 8, 8, 896, F.G, F.bid);
          pg8::EpiF32 E{(float*)(ws + WS_XG), 256};
          pg8::gemm_phase(F.lds, g, S, E); })
    PH(23, const int* TBL = (const int*)(ws + MOE_TBL); int nP = TBL[159]; nP = nP < 128 ? 128 : (nP > MOE_MAXP ? MOE_MAXP : nP);
        combine_tail(F, (const float*)(ws + WS_XG), (nP - 128) * 8, 8, 128, D / 256, (float*)(ws + WS_YG), 2, nullptr, 0, nullptr);)
    PH(24, p21_final(F);)
#undef IN
#undef SEAM
#undef PH
}

extern "C" void kernel_launch(void* const* d_in, const int* in_sizes, int n_in, void* d_out, int out_size, void* d_ws, size_t ws_size, hipStream_t stream) {
    static int grid = 0;
    if (grid == 0) {
        if (n_in != 36 || out_size != NL * D || ws_size < WS_END) { fprintf(stderr, "kernel_launch: unexpected problem (n_in %d, out %d, ws %zu < %zu)\n", n_in, out_size, ws_size, (size_t)WS_END); grid = -1; return; }
        int dev = 0, cus = 0, per_cu = 0;
        if (hipGetDevice(&dev) != hipSuccess || hipDeviceGetAttribute(&cus, hipDeviceAttributeMultiprocessorCount, dev) != hipSuccess) { grid = -1; return; }
        if (hipFuncSetAttribute((const void*)fwd_kernel, hipFuncAttributeMaxDynamicSharedMemorySize, LDS_BYTES) != hipSuccess) { fprintf(stderr, "kernel_launch: hipFuncSetAttribute failed\n"); grid = -1; return; }
        if (hipOccupancyMaxActiveBlocksPerMultiprocessor(&per_cu, (const void*)fwd_kernel, NWAVES * 64, LDS_BYTES) != hipSuccess || per_cu < 1) fprintf(stderr, "kernel_launch: occupancy query reports %d\n", per_cu);
        (void)hipGetLastError();
        grid = cus;
    }
    if (grid < 0) return;
    if (hipMemsetAsync((char*)d_ws + WS_CTL, 0, CTL_ZERO_BYTES, stream) != hipSuccess) return;
    Args a{};
    for (int i = 0; i < 36; ++i) a.in[i] = (const float*)d_in[i];
    a.out = (float*)d_out; a.ws = (unsigned char*)d_ws;
#if MK_LAUNCHES == 1
    a.ph_lo = 0; a.ph_hi = N_PHASES;
    hipLaunchKernelGGL(fwd_kernel, dim3(grid), dim3(NWAVES * 64), LDS_BYTES, stream, a);
#else
    for (int p = 0; p < N_PHASES; ++p) { a.ph_lo = p; a.ph_hi = p + 1; hipLaunchKernelGGL(fwd_kernel, dim3(grid), dim3(NWAVES * 64), LDS_BYTES, stream, a); }
#endif
}
```

```cpp
#include <hip/hip_runtime.h>
#include <cstdio>
#include <cstdint>

#ifndef MK_LAUNCHES
#define MK_LAUNCHES 1
#endif

#define LAS __attribute__((address_space(3)))
typedef unsigned short bf16_t;
typedef short bf16x8 __attribute__((ext_vector_type(8)));
typedef float f32x4 __attribute__((ext_vector_type(4)));
typedef float f32x2 __attribute__((ext_vector_type(2)));
typedef unsigned u32x4 __attribute__((ext_vector_type(4)));
typedef unsigned u32x2 __attribute__((ext_vector_type(2)));

constexpr int D = 2048, NB = 4, SEQ = 4096, CTXL = 256;
constexpr int NL = NB * SEQ;
constexpr int NC = NB * CTXL;
constexpr int MT = NL + NC;
constexpr int EIN = 6176, EINP = 6400;
constexpr int FFH = 5632, EXH = 7168, NEXP = 8;
constexpr float ALPHA = 1.41421356237f;
constexpr float EPS = 1e-6f;
constexpr int NMOD = 12288;
constexpr int S5ROWS = 1280, S5CH = 272;
constexpr int NCH = 68;
constexpr size_t DN_STRIDE = 73984, DN_W = 0, DN_QG = 16384, DN_KGT = 32768, DN_UT = 49152, DN_ATT = 65536, DN_GL = 73728;
constexpr size_t GL_STRIDE = 74752, GL_QIN = 0, GL_KDT = 32768, GL_ATT = 65536, GL_GL = 73728;
constexpr size_t GLV_STRIDE = 65536;
constexpr int MOE_MAXP = 136;

constexpr size_t MiB = 1u << 20;
constexpr size_t WS_CTL = 0, CTL_ZERO_BYTES = 1 * MiB;
constexpr size_t WS_MOD = 1 * MiB;
constexpr size_t WS_MOE = 2 * MiB;
constexpr size_t MOE_TOPK = WS_MOE, MOE_DEST = WS_MOE + 16384 * 16, MOE_HIST = MOE_DEST + 16384 * 8, MOE_TBL = MOE_HIST + 256 * 8 * 4, MOE_RT = MOE_TBL + 1024, MOE_STATS = MOE_RT + 8 * 2048 * 4;
constexpr size_t WS_S5W = 4 * MiB;
constexpr size_t WS_S5M = 12 * MiB;
constexpr size_t WS_WIN1 = 28 * MiB;
constexpr size_t WS_WOUT1 = 53 * MiB;
constexpr size_t WS_W13M = 61 * MiB;
constexpr size_t WS_W2M = 509 * MiB;
constexpr size_t WS_WIN0 = 733 * MiB;
constexpr size_t WS_WOUT0 = 758 * MiB;
constexpr size_t WS_W130 = 766 * MiB;
constexpr size_t WS_W20 = 810 * MiB;
constexpr size_t DYN = 832 * MiB;
constexpr size_t WS_XR = DYN;
constexpr size_t WS_P = DYN + 136 * MiB;
constexpr size_t WS_A1 = DYN + 349 * MiB;
constexpr size_t WS_AS5 = DYN + 417 * MiB;
constexpr size_t WS_E = DYN + 497 * MiB;
constexpr size_t WS_A0 = DYN + 577 * MiB;
constexpr size_t WS_QKVN = DYN + 645 * MiB;
constexpr size_t WS_DNB = DYN + 747 * MiB;
constexpr size_t WS_ODN = DYN + 497 * MiB;
constexpr size_t WS_H0 = DYN + 645 * MiB;
constexpr size_t WS_GLB = DYN + 645 * MiB;
constexpr size_t WS_GLV = DYN + 801 * MiB;
constexpr size_t WS_OGL = DYN + 349 * MiB;
constexpr size_t WS_A1B = DYN + 477 * MiB;
constexpr size_t WS_A2B = DYN + 541 * MiB;
constexpr size_t WS_XG = DYN + 136 * MiB;
constexpr size_t WS_HM = DYN + 272 * MiB;
constexpr size_t WS_YG = DYN + 748 * MiB;
constexpr size_t WS_END = DYN + 1056 * MiB;
static_assert(WS_DNB + 4352 * DN_STRIDE <= WS_END, "ws");
static_assert(WS_GLB + 2176 * GL_STRIDE <= WS_GLV && WS_GLV + 1088 * GLV_STRIDE <= WS_END, "ws");
static_assert(WS_YG + (size_t)34816 * 2048 * 4 <= WS_END, "ws");
static_assert(WS_HM + (size_t)34816 * 7168 * 2 <= WS_YG, "ws");
static_assert(WS_H0 + (size_t)MT * FFH * 2 <= WS_END, "ws");
static_assert(WS_ODN + (size_t)2 * MT * 1024 * 4 <= WS_QKVN, "ws");
static_assert(MOE_STATS + 17408 * 8 <= WS_S5W, "ws");
constexpr int CW_BAR = 4096;

constexpr int RING_BYTES = 131072;
constexpr int MISC_OFF = 147456 - 256;
constexpr int LDS_BYTES = 147456;

__device__ __forceinline__ unsigned f2bf(float f) { unsigned u = __builtin_bit_cast(unsigned, f); return (u + 0x7fffu + ((u >> 16) & 1u)) >> 16; }
typedef __bf16 bf16x2_t __attribute__((ext_vector_type(2)));
__device__ __forceinline__ unsigned pk2(float lo, float hi) { const f32x2 v = {lo, hi}; const bf16x2_t b = __builtin_convertvector(v, bf16x2_t); return __builtin_bit_cast(unsigned, b); }
__device__ __forceinline__ float bflo(unsigned u) { return __builtin_bit_cast(float, u << 16); }
__device__ __forceinline__ float bfhi(unsigned u) { return __builtin_bit_cast(float, u & 0xffff0000u); }
__device__ __forceinline__ float bf1(bf16_t b) { return __builtin_bit_cast(float, (unsigned)b << 16); }
__device__ __forceinline__ float wave_sum(float v) {
#pragma unroll
    for (int o = 1; o < 64; o <<= 1) v += __shfl_xor(v, o);
    return v;
}
__device__ __forceinline__ float sigmoidf_(float x) { return __builtin_amdgcn_rcpf(1.0f + __expf(-x)); }
__device__ __forceinline__ float siluf_(float x) { return x * __builtin_amdgcn_rcpf(1.0f + __expf(-x)); }
__device__ __forceinline__ float gelu_tanh(float x) { const float u = 0.7978845608f * (x + 0.044715f * x * x * x); const float e = __expf(2.0f * u); const float t = 1.0f - 2.0f * __builtin_amdgcn_rcpf(e + 1.0f); return 0.5f * x * (1.0f + t); }
__device__ __forceinline__ float softplusf_(float x) { return x > 20.f ? x : log1pf(__expf(x)); }
#define LDS_WAIT() asm volatile("s_waitcnt lgkmcnt(0)" ::: "memory")

#define XB_TMO      128
#define XB_XCNT(j)  (256  + 64 * (j))
#define XB_XSUB(j)  (1280 + 64 * (j))
#define XB_XGEN(j)  (2304 + 64 * (j))
#define XB_TOP      3328
#define XB_TOPGEN   3392
#define XCD_BAR_WORDS 3456
#define XB_SPIN_CAP (1u << 18)
__device__ __forceinline__ unsigned xb_ld(unsigned* p)              { return __hip_atomic_load(p, __ATOMIC_RELAXED, __HIP_MEMORY_SCOPE_AGENT); }
__device__ __forceinline__ unsigned xb_add(unsigned* p, unsigned v) { return __hip_atomic_fetch_add(p, v, __ATOMIC_RELAXED, __HIP_MEMORY_SCOPE_AGENT); }
__device__ __forceinline__ unsigned xb_xcc_id() { return (unsigned)__builtin_amdgcn_s_getreg((3 << 11) | 20) & 0xFu; }
#define XB_SPIN(cond, bar) do { unsigned _sp = 0; while (cond) { __builtin_amdgcn_s_sleep(1); \
    if ((++_sp & 255u) == 0u) { if (xb_ld(&(bar)[XB_TMO])) break; if (_sp > XB_SPIN_CAP) { atomicAdd(&(bar)[XB_TMO], 1u); break; } } } } while (0)
struct XcdBarrier { unsigned* bar; unsigned x; volatile LAS unsigned* st; };
__device__ __forceinline__ XcdBarrier xcd_barrier_post(unsigned* bar, volatile LAS unsigned* st) {
    XcdBarrier b; b.bar = bar; b.x = xb_xcc_id(); b.st = st;
    if (threadIdx.x == 0) (void)xb_add(&bar[XB_XCNT(b.x)], 1u);
    return b;
}
__device__ __forceinline__ void xcd_barrier_complete(unsigned* bar, unsigned x, unsigned& nloc, unsigned& nx) {
    const unsigned G = gridDim.x * gridDim.y * gridDim.z;
    unsigned sum, cnt, mine, sp = 0u;
    for (;;) {
        sum = 0u; cnt = 0u; mine = 0u;
#pragma unroll
        for (unsigned j = 0; j < 16; ++j) { const unsigned c = xb_ld(&bar[XB_XCNT(j)]); sum += c; cnt += (c > 0u) ? 1u : 0u; mine = (j == x) ? c : mine; }
        if (sum == G) break;
        __builtin_amdgcn_s_sleep(1);
        if ((++sp & 255u) == 0u) { if (xb_ld(&bar[XB_TMO])) break; if (sp > XB_SPIN_CAP) { atomicAdd(&bar[XB_TMO], 1u); break; } }
    }
    nloc = mine > 0u ? mine : 1u; nx = cnt > 0u ? cnt : 1u;
}
__device__ __forceinline__ void xcd_barrier(const XcdBarrier& b) {
    asm volatile("s_waitcnt vmcnt(0)" ::: "memory");
    __syncthreads();
    if (threadIdx.x == 0) {
        unsigned* bar = b.bar;
        __builtin_amdgcn_s_waitcnt(0);
        unsigned nloc = b.st[0], nx = b.st[1];
        if (nloc == 0u) { xcd_barrier_complete(bar, b.x, nloc, nx); b.st[0] = nloc; b.st[1] = nx; }
        const unsigned old = xb_add(&bar[XB_XSUB(b.x)], 1u);
        const unsigned gen = old / nloc;
        if (old + 1u == (gen + 1u) * nloc) {
            __builtin_amdgcn_fence(__ATOMIC_RELEASE, "agent");
            asm volatile("s_waitcnt vmcnt(0)" ::: "memory");
            const unsigned og = xb_add(&bar[XB_TOP], 1u);
            const unsigned tg = og / nx;
            if (og + 1u == (tg + 1u) * nx) xb_add(&bar[XB_TOPGEN], 1u);
            else XB_SPIN(xb_ld(&bar[XB_TOPGEN]) == tg, bar);
            __builtin_amdgcn_fence(__ATOMIC_ACQUIRE, "agent");
            xb_add(&bar[XB_XGEN(b.x)], 1u);
            asm volatile("s_waitcnt vmcnt(0)" ::: "memory");
        } else {
            XB_SPIN(xb_ld(&bar[XB_XGEN(b.x)]) == gen, bar);
            __builtin_amdgcn_fence(__ATOMIC_ACQUIRE, "agent");
            asm volatile("s_waitcnt vmcnt(0)" ::: "memory");
        }
    }
    __syncthreads();
}

namespace pg8 {
constexpr int BM = 256, BK = 64, HALF = 128, HTB = HALF * BK * 2, STAGE_BYTES = 8 * HTB, NXCD = 8, WGM = 8;
__host__ __device__ __forceinline__ int lds_byte(int r, int c) { const int st = (r >> 4) * 2 + (c >> 5), rr = r & 15, cc = c & 31, ob = rr * 64 + cc * 2; return st * 1024 + (ob ^ (((ob >> 9) & 1) << 5)); }
__host__ __device__ __forceinline__ void stage_rc(int b, int& R, int& C) { const int st = b / 1024, sb = b % 1024, swz = sb ^ (((sb >> 9) & 1) << 5); R = (st >> 1) * 16 + swz / 64; C = (st & 1) * 32 + (swz % 64) / 2; }
__host__ __device__ __forceinline__ int perm32(int rho) { const int n = rho >> 4, i = rho & 15; return 8 * (i >> 2) + 4 * n + (i & 3); }

struct Unit { int pm, pn; const char* a; const char* b; };
struct Gemm { int lda, ldb, K; };

struct SchedDense {
    const char* A; const char* B; size_t a_t, b_t; int nM, nN, nwg, G, c;
    __device__ void init(const void* A_, const void* B_, int lda, int ldb, int nM_, int nN_, int G_, int c_) { A = (const char*)A_; B = (const char*)B_; a_t = (size_t)BM * lda * 2; b_t = (size_t)BM * ldb * 2; nM = nM_; nN = nN_; nwg = nM * nN; G = G_; c = c_; }
    __device__ bool next(int i, Unit& u) const {
        const long L = (long)i * G + c; if (L >= nwg) return false;
        int wgid = (int)L; { const int q = nwg / NXCD, r = nwg % NXCD, xcd = wgid % NXCD, off = wgid / NXCD; wgid = (xcd < r ? xcd * (q + 1) : r * (q + 1) + (xcd - r) * q) + off; }
        const int nig = WGM * nN, gid = wgid / nig, fm = gid * WGM, gsz = (nM - fm) < WGM ? (nM - fm) : WGM;
        u.pm = fm + ((wgid % nig) % gsz); u.pn = (wgid % nig) / gsz; u.a = A + (size_t)u.pm * a_t; u.b = B + (size_t)u.pn * b_t; return true;
    }
};
struct SchedGroup {
    const char* A; const char* B; size_t a_t, b_t, b_e; const int* tbl; int div, nP, nN, nwg, G, c;
    __device__ void init(const void* A_, const void* B_, int lda, int ldb, size_t b_e_, const int* tbl_, int div_, int nP_, int nN_, int G_, int c_) { A = (const char*)A_; B = (const char*)B_; a_t = (size_t)BM * lda * 2; b_t = (size_t)BM * ldb * 2; b_e = b_e_; tbl = tbl_; div = div_; nP = nP_; nN = nN_; nwg = nP * nN; G = G_; c = c_; }
    __device__ bool next(int i, Unit& u) const {
        const long L = (long)i * G + c; if (L >= nwg) return false;
        int wgid = (int)L; { const int q = nwg / NXCD, r = nwg % NXCD, xcd = wgid % NXCD, off = wgid / NXCD; wgid = (xcd < r ? xcd * (q + 1) : r * (q + 1) + (xcd - r) * q) + off; }
        const int nig = WGM * nN, gid = wgid / nig, fm = gid * WGM, gsz = (nP - fm) < WGM ? (nP - fm) : WGM;
        u.pm = fm + ((wgid % nig) % gsz); u.pn = (wgid % nig) / gsz; const int e = tbl ? tbl[u.pm] : u.pm / div;
        u.a = A + (size_t)u.pm * a_t; u.b = B + (size_t)e * b_e + (size_t)u.pn * b_t; return true;
    }
};

struct SchedSplit {
    const char* A; const char* B; size_t a_t, b_t, b_e, ksb; const int* tbl; int pm0, nN, S, nsub, G, c;
    __device__ void init(const void* A_, const void* B_, int lda, int ldb, size_t b_e_, const int* tbl_, int pm0_, int nN_, int U, int S_, int Ksub, int G_, int c_) { A = (const char*)A_; B = (const char*)B_; a_t = (size_t)BM * lda * 2; b_t = (size_t)BM * ldb * 2; b_e = b_e_; ksb = (size_t)Ksub * 2; tbl = tbl_; pm0 = pm0_; nN = nN_; S = S_; nsub = U * S_; G = G_; c = c_; }
    __device__ bool next(int i, Unit& u) const {
        const long L = (long)i * G + c; if (L >= nsub) return false;
        const int uu = (int)(L / S), sx = (int)(L % S), pm = pm0 + uu / nN, pn = uu % nN; const int e = tbl ? tbl[pm] : 0;
        u.pm = (int)L; u.pn = 0; u.a = A + (size_t)pm * a_t + sx * ksb; u.b = B + (size_t)e * b_e + (size_t)pn * b_t + sx * ksb; return true;
    }
};
template <class Epi, class Sched>
__device__ __forceinline__ void gemm_phase(LAS unsigned char* lds, const Gemm g, const Sched& S, const Epi& E) {
    const int tid = threadIdx.x, wid = __builtin_amdgcn_readfirstlane(tid >> 6), lane = tid & 63, wr = wid >> 2, wc = wid & 3, fr = lane & 15, fq = lane >> 4;
    const int K = g.K, nt = K / BK;
    unsigned voffA[2], voffB[2];
#pragma unroll
    for (int i = 0; i < 2; ++i) { int R, C; stage_rc(tid * 16 + i * 8192, R, C); const int Rb = Epi::PERM ? ((R & ~31) + perm32(R & 31)) : R;
        voffA[i] = (unsigned)(R * g.lda + C) * 2u; voffB[i] = (unsigned)(Rb * g.ldb + C) * 2u; }
    const size_t kstep = (size_t)(BK * 2);
    const size_t hA = (size_t)HALF * g.lda * 2, hB = (size_t)HALF * g.ldb * 2;
    const unsigned ldsw = (unsigned)wid * 1024u;
    const int aoff = lds_byte(wr * 64 + fr, fq * 8), boff = lds_byte(wc * 32 + fr, fq * 8);
#define PG8_SA(b, h) (((b) * 2 + (h)) * HTB)
#define PG8_SB(b, h) ((4 + (b) * 2 + (h)) * HTB)
#define PG8_STAGE(bufoff, gbase, voff) do { _Pragma("unroll") for (int _i = 0; _i < 2; ++_i) \
        __builtin_amdgcn_global_load_lds((const unsigned*)((const char*)(gbase) + (voff)[_i]), (LAS unsigned*)(lds + (bufoff) + ldsw + _i * 8192), 16, 0, 0); } while (0)
#define PG8_LDA(dst, b, h) do { _Pragma("unroll") for (int m = 0; m < 4; ++m) _Pragma("unroll") for (int k = 0; k < 2; ++k) dst[m][k] = *(const LAS bf16x8*)(lds + PG8_SA(b, h) + aoff + m * 2048 + k * 1024); } while (0)
#define PG8_LDB(dst, b, h) do { _Pragma("unroll") for (int n = 0; n < 2; ++n) _Pragma("unroll") for (int k = 0; k < 2; ++k) dst[n][k] = *(const LAS bf16x8*)(lds + PG8_SB(b, h) + boff + n * 2048 + k * 1024); } while (0)
#define PG8_MMA(ai, bj, At, Bt) do { __builtin_amdgcn_s_setprio(1); _Pragma("unroll") for (int m = 0; m < 4; ++m) _Pragma("unroll") for (int n = 0; n < 2; ++n) _Pragma("unroll") for (int k = 0; k < 2; ++k) \
        acc[ai][bj][m][n] = __builtin_amdgcn_mfma_f32_16x16x32_bf16(Bt[n][k], At[m][k], acc[ai][bj][m][n], 0, 0, 0); __builtin_amdgcn_s_setprio(0); } while (0)
#define PG8_WAIT_V(n) asm volatile("s_waitcnt vmcnt(" #n ")" ::: "memory")
#define PG8_WAIT_L(n) asm volatile("s_waitcnt lgkmcnt(" #n ")" ::: "memory")
#define PG8_BAR __builtin_amdgcn_s_barrier()
#define PG8_SCHED __builtin_amdgcn_sched_barrier(0)
    Unit cur, nxt; int ui = 0;
    if (!S.next(0, cur)) return;
    f32x4 acc[2][2][4][2];
#pragma unroll
    for (int a = 0; a < 2; ++a)
#pragma unroll
        for (int b = 0; b < 2; ++b)
#pragma unroll
            for (int m = 0; m < 4; ++m)
#pragma unroll
                for (int n = 0; n < 2; ++n) acc[a][b][m][n] = (f32x4){0.f, 0.f, 0.f, 0.f};
    bf16x8 At[4][2], B0[2][2], B1[2][2];
    const char* cA = cur.a; const char* cB = cur.b;
    PG8_STAGE(PG8_SB(0, 0), cB, voffB); PG8_STAGE(PG8_SB(0, 1), cB + hB, voffB); PG8_STAGE(PG8_SA(0, 0), cA, voffA); PG8_STAGE(PG8_SA(0, 1), cA + hA, voffA);
    if (wr == 1) PG8_BAR;
    PG8_WAIT_V(2); PG8_BAR;
    PG8_STAGE(PG8_SB(1, 0), cB + kstep, voffB); PG8_STAGE(PG8_SA(1, 0), cA + kstep, voffA); PG8_STAGE(PG8_SB(1, 1), cB + hB + kstep, voffB);
    PG8_WAIT_V(6); PG8_BAR;
    for (;;) {
        const bool has_next = S.next(ui + 1, nxt);
        const char* nA = has_next ? nxt.a : cA; const char* nB = has_next ? nxt.b : cB;
        for (int t = 0; t < nt; t += 2) {
            const bool last = (t == nt - 2);
            const char* a1 = cA + (size_t)(t + 1) * kstep;
            const char* a2 = last ? nA : cA + (size_t)(t + 2) * kstep; const char* b2 = last ? nB : cB + (size_t)(t + 2) * kstep;
            const char* a3 = a2 + kstep; const char* b3 = b2 + kstep;
            PG8_LDB(B0, 0, 0); PG8_LDB(B1, 0, 1); PG8_SCHED; PG8_LDA(At, 0, 0); PG8_STAGE(PG8_SA(1, 1), a1 + hA, voffA);
            PG8_WAIT_V(8); PG8_WAIT_L(0); PG8_BAR; PG8_MMA(0, 0, At, B0); PG8_MMA(0, 1, At, B1); PG8_BAR; PG8_SCHED;
            PG8_LDA(At, 0, 1); PG8_STAGE(PG8_SB(0, 0), b2, voffB); PG8_STAGE(PG8_SB(0, 1), b2 + hB, voffB); PG8_STAGE(PG8_SA(0, 0), a2, voffA);
            PG8_WAIT_V(8); PG8_WAIT_L(0); PG8_BAR; PG8_MMA(1, 0, At, B0); PG8_MMA(1, 1, At, B1); PG8_BAR; PG8_SCHED;
            PG8_LDB(B0, 1, 0); PG8_LDB(B1, 1, 1); PG8_SCHED; PG8_LDA(At, 1, 0); PG8_STAGE(PG8_SA(0, 1), a2 + hA, voffA);
            PG8_WAIT_V(8); PG8_WAIT_L(0); PG8_BAR; PG8_MMA(0, 0, At, B0); PG8_MMA(0, 1, At, B1); PG8_BAR; PG8_SCHED;
            PG8_LDA(At, 1, 1); PG8_STAGE(PG8_SB(1, 0), b3, voffB); PG8_STAGE(PG8_SB(1, 1), b3 + hB, voffB); PG8_STAGE(PG8_SA(1, 0), a3, voffA);
            PG8_WAIT_V(8); PG8_WAIT_L(0); PG8_BAR; PG8_MMA(1, 0, At, B0); PG8_MMA(1, 1, At, B1); PG8_BAR; PG8_SCHED;
        }
        if (wr == 0) PG8_BAR;
        E(acc, cur, wr, wc, fr, fq);
        if (!has_next) break;
#pragma unroll
        for (int a = 0; a < 2; ++a)
#pragma unroll
            for (int b = 0; b < 2; ++b)
#pragma unroll
                for (int m = 0; m < 4; ++m)
#pragma unroll
                    for (int n = 0; n < 2; ++n) acc[a][b][m][n] = (f32x4){0.f, 0.f, 0.f, 0.f};
        cur = nxt; cA = nA; cB = nB; ++ui;
        if (wr == 1) PG8_BAR;
    }
    PG8_WAIT_V(0);
    PG8_BAR;
#undef PG8_SA
#undef PG8_SB
#undef PG8_STAGE
#undef PG8_LDA
#undef PG8_LDB
#undef PG8_MMA
#undef PG8_WAIT_V
#undef PG8_WAIT_L
#undef PG8_BAR
#undef PG8_SCHED
}

struct EpiP0 {
    static constexpr bool PERM = true;
    bf16_t* P; bf16_t* As5;
    __device__ __forceinline__ void operator()(const f32x4 (&acc)[2][2][4][2], const Unit& u, int wr, int wc, int fr, int fq) const {
        const int row0 = u.pm * BM + wr * 64 + fr, col0 = u.pn * BM + wc * 32 + 8 * fq;
        const bool s5 = (u.pn >= 16 && u.pn < 20);
#pragma unroll
        for (int ai = 0; ai < 2; ++ai)
#pragma unroll
            for (int m = 0; m < 4; ++m) { const int r = row0 + ai * HALF + m * 16; bf16_t* rowp = P + (size_t)r * EINP + col0;
                int mrow, s;
                if (r < NL) { const int b = r >> 12, t = r & 4095; mrow = (16 + (t >> 4)) * 4 + b; s = t & 15; } else { const int rr = r - NL, b = rr >> 8, t = rr & 255; mrow = (t >> 4) * 4 + b; s = t & 15; }
#pragma unroll
                for (int bj = 0; bj < 2; ++bj) { const f32x4 v0 = acc[ai][bj][m][0], v1 = acc[ai][bj][m][1];
                    u32x4 w; w.x = pk2(v0[0], v0[1]); w.y = pk2(v0[2], v0[3]); w.z = pk2(v1[0], v1[1]); w.w = pk2(v1[2], v1[3]);
                    *(u32x4*)(rowp + bj * HALF) = w;
                    if (s5) { const int c0 = col0 + bj * HALF - 4096, gg = c0 >> 4, h0 = c0 & 15;
                        *(u32x4*)(As5 + ((size_t)(gg * S5ROWS + mrow) * 512 + s * 16 + h0)) = w; } } }
    }
};
struct EpiBf {
    static constexpr bool PERM = true;
    bf16_t* O; int ldc;
    __device__ __forceinline__ void operator()(const f32x4 (&acc)[2][2][4][2], const Unit& u, int wr, int wc, int fr, int fq) const {
        const int row0 = u.pm * BM + wr * 64 + fr, col0 = u.pn * BM + wc * 32 + 8 * fq;
#pragma unroll
        for (int ai = 0; ai < 2; ++ai)
#pragma unroll
            for (int m = 0; m < 4; ++m) { bf16_t* rowp = O + (size_t)(row0 + ai * HALF + m * 16) * ldc + col0;
#pragma unroll
                for (int bj = 0; bj < 2; ++bj) { const f32x4 v0 = acc[ai][bj][m][0], v1 = acc[ai][bj][m][1];
                    u32x4 w; w.x = pk2(v0[0], v0[1]); w.y = pk2(v0[2], v0[3]); w.z = pk2(v1[0], v1[1]); w.w = pk2(v1[2], v1[3]);
                    *(u32x4*)(rowp + bj * HALF) = w; } }
    }
};
struct EpiF32 {
    static constexpr bool PERM = false;
    float* C; int ldc;
    __device__ __forceinline__ void operator()(const f32x4 (&acc)[2][2][4][2], const Unit& u, int wr, int wc, int fr, int fq) const {
        const int row0 = u.pm * BM + wr * 64 + fr, col0 = u.pn * BM + wc * 32 + 4 * fq;
#pragma unroll
        for (int ai = 0; ai < 2; ++ai)
#pragma unroll
            for (int m = 0; m < 4; ++m) { float* rowp = C + (size_t)(row0 + ai * HALF + m * 16) * ldc + col0;
#pragma unroll
                for (int bj = 0; bj < 2; ++bj)
#pragma unroll
                    for (int n = 0; n < 2; ++n) *(f32x4*)(rowp + bj * HALF + n * 16) = acc[ai][bj][m][n]; }
    }
};
template <bool B> struct ResT { typedef f32x4 raw; typedef float elem; };
template <> struct ResT<true> { typedef u32x2 raw; typedef bf16_t elem; };
__device__ __forceinline__ f32x4 res_cvt(f32x4 x) { return x; }
__device__ __forceinline__ f32x4 res_cvt(u32x2 q) { return (f32x4){bflo(q.x), bfhi(q.x), bflo(q.y), bfhi(q.y)}; }
template <bool STATS>
struct EpiYT {
    typedef typename ResT<STATS>::raw RawT; typedef typename ResT<STATS>::elem ElT;
    static constexpr bool PERM = false;
    const ElT* resL; const ElT* resC; bf16_t* Y; const float* gate;
    const float* stats; const float* lg; const float* lb;
    __device__ __forceinline__ void operator()(const f32x4 (&acc)[2][2][4][2], const Unit& u, int wr, int wc, int fr, int fq) const {
        const int row0 = u.pm * BM + wr * 64 + fr, col0 = u.pn * BM + wc * 32 + 4 * fq;
        const int mb = u.pm < 64 ? (u.pm >> 4) : 4;
        const float* gp = gate + (size_t)mb * NMOD + col0;
        const ElT* rbase = (u.pm < 64 ? resL : resC - (size_t)NL * D) + (size_t)row0 * D + col0; bf16_t* ybase = Y + (size_t)row0 * D + col0;
        f32x2 st[2][4];
        if (STATS) {
#pragma unroll
            for (int ai = 0; ai < 2; ++ai)
#pragma unroll
                for (int m = 0; m < 4; ++m) st[ai][m] = *(const f32x2*)(stats + (size_t)(row0 + ai * HALF + m * 16) * 2); }
        RawT rv[2][2][4];
#pragma unroll
        for (int ai = 0; ai < 2; ++ai)
#pragma unroll
            for (int m = 0; m < 4; ++m) rv[0][ai][m] = *(const RawT*)(rbase + (size_t)(ai * HALF + m * 16) * D);
#pragma unroll
        for (int g = 0; g < 4; ++g) { const int bj = g >> 1, n = g & 1; const int co = bj * HALF + n * 16; const f32x4 gv = *(const f32x4*)(gp + co);
            f32x4 gg = {1.f, 1.f, 1.f, 1.f}, bb = {0.f, 0.f, 0.f, 0.f}; if (STATS) { gg = *(const f32x4*)(lg + col0 + co); bb = *(const f32x4*)(lb + col0 + co); }
            if (g < 3) { const int co1 = ((g + 1) >> 1) * HALF + ((g + 1) & 1) * 16;
#pragma unroll
                for (int ai = 0; ai < 2; ++ai)
#pragma unroll
                    for (int m = 0; m < 4; ++m) rv[(g + 1) & 1][ai][m] = *(const RawT*)(rbase + (size_t)(ai * HALF + m * 16) * D + co1); }
#pragma unroll
            for (int ai = 0; ai < 2; ++ai)
#pragma unroll
                for (int m = 0; m < 4; ++m) { f32x4 r = res_cvt(rv[g & 1][ai][m]); if (STATS) r = (r - st[ai][m].x) * st[ai][m].y * gg + bb;
                    const f32x4 y = r * ALPHA + gv * acc[ai][bj][m][n]; u32x2 w; w.x = pk2(y[0], y[1]); w.y = pk2(y[2], y[3]); *(u32x2*)(ybase + (size_t)(ai * HALF + m * 16) * D + co) = w; } }
    }
};
struct EpiYB {
    static constexpr bool PERM = true;
    const bf16_t* resL; const bf16_t* resC; bf16_t* Y; const float* gate;
    const float* stats; const float* lg; const float* lb;
    __device__ __forceinline__ void operator()(const f32x4 (&acc)[2][2][4][2], const Unit& u, int wr, int wc, int fr, int fq) const {
        const int row0 = u.pm * BM + wr * 64 + fr, col0 = u.pn * BM + wc * 32 + 8 * fq;
        const int mb = u.pm < 64 ? (u.pm >> 4) : 4;
        const float* gp = gate + (size_t)mb * NMOD + col0;
        const bf16_t* rbase = (u.pm < 64 ? resL : resC - (size_t)NL * D) + (size_t)row0 * D + col0; bf16_t* ybase = Y + (size_t)row0 * D + col0;
        u32x4 rv[4]; f32x2 st4[4];
#pragma unroll
        for (int m = 0; m < 4; ++m) { rv[m] = *(const u32x4*)(rbase + (size_t)(m * 16) * D); st4[m] = *(const f32x2*)(stats + (size_t)(row0 + m * 16) * 2); }
        f32x4 gv0, gv1, gg0, gg1, bb0, bb1;
#pragma unroll
        for (int bt = 0; bt < 4; ++bt) { const int bj = bt >> 1, ai = bt & 1, co = bj * HALF;
            if (ai == 0) { gv0 = *(const f32x4*)(gp + co); gv1 = *(const f32x4*)(gp + co + 4); gg0 = *(const f32x4*)(lg + col0 + co); gg1 = *(const f32x4*)(lg + col0 + co + 4); bb0 = *(const f32x4*)(lb + col0 + co); bb1 = *(const f32x4*)(lb + col0 + co + 4); }
            u32x4 w[4];
#pragma unroll
            for (int m = 0; m < 4; ++m) { const u32x4 q = rv[m];
                f32x4 r0 = {bflo(q.x), bfhi(q.x), bflo(q.y), bfhi(q.y)}, r1 = {bflo(q.z), bfhi(q.z), bflo(q.w), bfhi(q.w)};
                r0 = (r0 - st4[m].x) * st4[m].y * gg0 + bb0; r1 = (r1 - st4[m].x) * st4[m].y * gg1 + bb1;
                const f32x4 y0 = r0 * ALPHA + gv0 * acc[ai][bj][m][0], y1 = r1 * ALPHA + gv1 * acc[ai][bj][m][1];
                w[m].x = pk2(y0[0], y0[1]); w[m].y = pk2(y0[2], y0[3]); w[m].z = pk2(y1[0], y1[1]); w[m].w = pk2(y1[2], y1[3]); }
            if (bt < 3) { const int bj1 = (bt + 1) >> 1, ai1 = (bt + 1) & 1;
#pragma unroll
                for (int m = 0; m < 4; ++m) { rv[m] = *(const u32x4*)(rbase + (size_t)(ai1 * HALF + m * 16) * D + bj1 * HALF); st4[m] = *(const f32x2*)(stats + (size_t)(row0 + ai1 * HALF + m * 16) * 2); } }
#pragma unroll
            for (int m = 0; m < 4; ++m) *(u32x4*)(ybase + (size_t)(ai * HALF + m * 16) * D + co) = w[m]; }
    }
};
struct EpiYF {
    static constexpr bool PERM = true;
    const float* resL; const float* resC; bf16_t* Y; const float* gate;
    __device__ __forceinline__ void operator()(const f32x4 (&acc)[2][2][4][2], const Unit& u, int wr, int wc, int fr, int fq) const {
        const int row0 = u.pm * BM + wr * 64 + fr, col0 = u.pn * BM + wc * 32 + 8 * fq;
        const int mb = u.pm < 64 ? (u.pm >> 4) : 4;
        const float* gp = gate + (size_t)mb * NMOD + col0;
        const float* rbase = (u.pm < 64 ? resL : resC - (size_t)NL * D) + (size_t)row0 * D + col0; bf16_t* ybase = Y + (size_t)row0 * D + col0;
#pragma unroll
        for (int bj = 0; bj < 2; ++bj) { const int co = bj * HALF;
            const f32x4 gv0 = *(const f32x4*)(gp + co), gv1 = *(const f32x4*)(gp + co + 4);
#pragma unroll
            for (int ai = 0; ai < 2; ++ai) { f32x4 ra[4], rb[4];
#pragma unroll
                for (int m = 0; m < 4; ++m) { const float* rp = rbase + (size_t)(ai * HALF + m * 16) * D + co; ra[m] = *(const f32x4*)rp; rb[m] = *(const f32x4*)(rp + 4); }
#pragma unroll
                for (int m = 0; m < 4; ++m) { const f32x4 y0 = ra[m] * ALPHA + gv0 * acc[ai][bj][m][0], y1 = rb[m] * ALPHA + gv1 * acc[ai][bj][m][1];
                    u32x4 w; w.x = pk2(y0[0], y0[1]); w.y = pk2(y0[2], y0[3]); w.z = pk2(y1[0], y1[1]); w.w = pk2(y1[2], y1[3]);
                    *(u32x4*)(ybase + (size_t)(ai * HALF + m * 16) * D + co) = w; } } }
    }
};
struct EpiH {
    static constexpr bool PERM = true;
    bf16_t* H; int ldc;
    __device__ __forceinline__ void operator()(const f32x4 (&acc)[2][2][4][2], const Unit& u, int wr, int wc, int fr, int fq) const {
        const int row0 = u.pm * BM + wr * 64 + fr, col0 = u.pn * HALF + wc * 32 + 8 * fq;
#pragma unroll
        for (int ai = 0; ai < 2; ++ai)
#pragma unroll
            for (int m = 0; m < 4; ++m) { bf16_t* rowp = H + (size_t)(row0 + ai * HALF + m * 16) * ldc + col0;
                const f32x4 g0 = acc[ai][0][m][0], g1 = acc[ai][0][m][1], u0 = acc[ai][1][m][0], u1 = acc[ai][1][m][1];
                float o[8];
#pragma unroll
                for (int j = 0; j < 4; ++j) { o[j] = siluf_(g0[j]) * u0[j]; o[4 + j] = siluf_(g1[j]) * u1[j]; }
                u32x4 w; w.x = pk2(o[0], o[1]); w.y = pk2(o[2], o[3]); w.z = pk2(o[4], o[5]); w.w = pk2(o[6], o[7]);
                *(u32x4*)rowp = w; }
    }
};
struct EpiS5C {
    static constexpr bool PERM = true;
    const bf16_t* P; bf16_t* A1; const float* dskip;
    __device__ __forceinline__ void operator()(const f32x4 (&acc)[2][2][4][2], const Unit& u, int wr, int wc, int fr, int fq) const {
        const int gg = u.pm / 5, panel = u.pm % 5;
#pragma unroll
        for (int ai = 0; ai < 2; ++ai)
#pragma unroll
            for (int m = 0; m < 4; ++m) { const int mrow = panel * BM + ai * HALF + wr * 64 + m * 16 + fr;
                if (mrow < NB * S5CH) { const int b = mrow & 3, chunk = mrow >> 2;
#pragma unroll
                    for (int bj = 0; bj < 2; ++bj) { const int n0 = bj * HALF + wc * 32 + 8 * fq, t = n0 >> 4, h0 = n0 & 15;
                        const int r = chunk < 16 ? NL + b * CTXL + chunk * 16 + t : b * SEQ + (chunk - 16) * 16 + t;
                        const int ch = gg * 16 + h0;
                        const u32x4 uv = *(const u32x4*)(P + (size_t)r * EINP + 4096 + ch), gv = *(const u32x4*)(P + (size_t)r * EINP + 5120 + ch);
                        const f32x4 d0 = *(const f32x4*)(dskip + ch), d1 = *(const f32x4*)(dskip + ch + 4);
                        const f32x4 v0 = acc[ai][bj][m][0], v1 = acc[ai][bj][m][1];
                        float y[8], uu[8], gt[8];
                        uu[0] = bflo(uv.x); uu[1] = bfhi(uv.x); uu[2] = bflo(uv.y); uu[3] = bfhi(uv.y); uu[4] = bflo(uv.z); uu[5] = bfhi(uv.z); uu[6] = bflo(uv.w); uu[7] = bfhi(uv.w);
                        gt[0] = bflo(gv.x); gt[1] = bfhi(gv.x); gt[2] = bflo(gv.y); gt[3] = bfhi(gv.y); gt[4] = bflo(gv.z); gt[5] = bfhi(gv.z); gt[6] = bflo(gv.w); gt[7] = bfhi(gv.w);
#pragma unroll
                        for (int j = 0; j < 4; ++j) { y[j] = v0[j] + d0[j] * uu[j]; y[4 + j] = v1[j] + d1[j] * uu[4 + j]; }
#pragma unroll
                        for (int j = 0; j < 8; ++j) y[j] = gelu_tanh(y[j]) * sigmoidf_(gt[j]);
                        u32x4 w; w.x = pk2(y[0], y[1]); w.y = pk2(y[2], y[3]); w.z = pk2(y[4], y[5]); w.w = pk2(y[6], y[7]);
                        *(u32x4*)(A1 + (size_t)r * D + ch) = w; } } }
    }
};
}

constexpr int NWAVES = 8;
struct Args { const float* in[36]; float* out; unsigned char* ws; int ph_lo, ph_hi; };
struct Frame {
    LAS unsigned char* lds; unsigned char* ldsg;
    int tid, lane, wave, G, bid;
    const Args* ap; float* out; unsigned char* ws;
};
enum { I_X = 0, I_C, I_CTX, I_CCTX, I_ADAW, I_ADAB, I_LN1G, I_LN1B, I_LN2G, I_LN2B, I_EWIN, I_LAMRE, I_LAMIM, I_LOGSTEP, I_BRE, I_BIM, I_CRE, I_CIM, I_S5D, I_DNCONV, I_DNALOG, I_DNDT, I_DNNORM,
       I_EWOUT, I_FW1, I_FW3, I_FW2, I_OWIN, I_GLAW2, I_GLAB, I_GLANORM, I_OWOUT, I_ROUTER, I_MW1, I_MW3, I_MW2 };

__device__ __forceinline__ int tok_row(int b, int d, int n, int i) {
    if (n < 4) { const int t = 64 * n + i; return NL + b * CTXL + (d ? 255 - t : t); }
    const int t = 64 * (n - 4) + i; return b * SEQ + (d ? 4095 - t : t);
}

__device__ __forceinline__ void p0_transpose_item(const float* W, int K, int N, bf16_t* WT, int kb, int n0, int drow0, float* scr, int lane) {
    const int k0 = 64 * kb;
    f32x4 v[8];
#pragma unroll
    for (int i = 0; i < 8; ++i) v[i] = *(const f32x4*)(W + (size_t)(k0 + 8 * i + (lane >> 3)) * N + n0 + 4 * (lane & 7));
#pragma unroll
    for (int i = 0; i < 8; ++i) { float* d = scr + (8 * i + (lane >> 3)) * 33 + 4 * (lane & 7); d[0] = v[i][0]; d[1] = v[i][1]; d[2] = v[i][2]; d[3] = v[i][3]; }
    LDS_WAIT(); asm volatile("" ::: "memory");
    const int c = lane & 7;
#pragma unroll
    for (int j = 0; j < 4; ++j) { const int n = (lane >> 3) + 8 * j; const float* s = scr + (8 * c) * 33 + n;
        u32x4 o; o.x = pk2(s[0 * 33], s[1 * 33]); o.y = pk2(s[2 * 33], s[3 * 33]); o.z = pk2(s[4 * 33], s[5 * 33]); o.w = pk2(s[6 * 33], s[7 * 33]);
        *(u32x4*)(WT + (size_t)(drow0 + n) * K + k0 + 8 * c) = o; }
    LDS_WAIT(); asm volatile("" ::: "memory");
}
__device__ __forceinline__ int il_row(int n0, int which) { return (n0 >> 7) * 256 + which * 128 + (n0 & 127); }

__device__ __forceinline__ void p0_adaln_item(Frame& F, int item) {
    const int layer = item / 96, cb = item % 96;
    float* sl = (float*)F.ldsg;
    float* red = (float*)(F.ldsg + 40960);
    const float* c = F.ap->in[I_C]; const float* cc = F.ap->in[I_CCTX];
    for (int i = F.tid; i < 5 * D; i += 512) { const int r = i / D, k = i % D; const float v = r < 4 ? c[r * D + k] : cc[k]; sl[i] = siluf_(v); }
    __syncthreads();
    const int q4 = 4 * (F.lane & 31), kh = F.lane >> 5;
    const float* W = F.ap->in[I_ADAW] + (size_t)layer * D * NMOD + cb * 128 + q4;
    f32x4 acc[5];
#pragma unroll
    for (int r = 0; r < 5; ++r) acc[r] = (f32x4){0.f, 0.f, 0.f, 0.f};
    const int kbeg = F.wave * 256;
#pragma unroll 1
    for (int k = kbeg; k < kbeg + 256; k += 32) {
        f32x4 w[16];
#pragma unroll
        for (int j = 0; j < 16; ++j) w[j] = *(const f32x4*)(W + (size_t)(k + 2 * j + kh) * NMOD);
#pragma unroll
        for (int j = 0; j < 16; ++j)
#pragma unroll
            for (int r = 0; r < 5; ++r) acc[r] += w[j] * sl[r * D + k + 2 * j + kh];
    }
#pragma unroll
    for (int r = 0; r < 5; ++r) {
#pragma unroll
        for (int c4 = 0; c4 < 4; ++c4) acc[r][c4] += __shfl_xor(acc[r][c4], 32);
        if (kh == 0) *(f32x4*)(red + (F.wave * 5 + r) * 128 + q4) = acc[r]; }
    __syncthreads();
    float* MOD = (float*)(F.ws + WS_MOD);
    for (int i = F.tid; i < 5 * 128; i += 512) { const int r = i / 128, cidx = i % 128; float s = 0.f;
#pragma unroll
        for (int w = 0; w < 8; ++w) s += red[(w * 5 + r) * 128 + cidx];
        const int col = cb * 128 + cidx; MOD[(size_t)(layer * 5 + r) * NMOD + col] = s + F.ap->in[I_ADAB][layer * NMOD + col]; }
    __syncthreads();
}

__device__ __forceinline__ void p0_s5_item(Frame& F, int g) {
    float* Ap = (float*)F.ldsg;
    float* BB = Ap + 2 * 64 * 17 * 2;
    float* Cc = BB + 2 * 64 * 16 * 2;
    float* Kt = Cc + 2 * 16 * 64 * 2;
    const float* lam_re = F.ap->in[I_LAMRE]; const float* lam_im = F.ap->in[I_LAMIM]; const float* lstep = F.ap->in[I_LOGSTEP];
    const float* bre = F.ap->in[I_BRE]; const float* bim = F.ap->in[I_BIM]; const float* cre = F.ap->in[I_CRE]; const float* cim = F.ap->in[I_CIM];
    for (int i = F.tid; i < 2 * 64 * 17; i += 512) { const int l = i % 17, p = (i / 17) % 64, d = i / (17 * 64);
        const float delta = __expf(lstep[d * 64 + g]); const float lr = lam_re[(d * 64 + g) * 64 + p], li = lam_im[(d * 64 + g) * 64 + p];
        const float mag = expf(lr * delta * (float)l); float sn, cs; sincosf(li * delta * (float)l, &sn, &cs);
        Ap[i * 2] = mag * cs; Ap[i * 2 + 1] = mag * sn; }
    for (int i = F.tid; i < 2 * 64 * 16; i += 512) { const int h = i % 16, p = (i / 16) % 64, d = i / (16 * 64);
        const float delta = __expf(lstep[d * 64 + g]); const float lr = lam_re[(d * 64 + g) * 64 + p], li = lam_im[(d * 64 + g) * 64 + p];
        const float x = lr * delta, y = li * delta; float sn, cs; sincosf(y, &sn, &cs); float sh, ch_; sincosf(0.5f * y, &sh, &ch_); (void)ch_;
        const float em1 = expm1f(x); const float are1 = em1 * cs - 2.f * sh * sh;
        const float aim = (em1 + 1.f) * sn; const float den = lr * lr + li * li;
        const float fre = (are1 * lr + aim * li) / den, fim = (aim * lr - are1 * li) / den;
        const size_t bi = ((size_t)((d * 64 + g) * 64 + p)) * 16 + h; const float br = bre[bi], bi_ = bim[bi];
        BB[i * 2] = fre * br - fim * bi_; BB[i * 2 + 1] = fre * bi_ + fim * br; }
    for (int i = F.tid; i < 2 * 16 * 64; i += 512) { const int p = i % 64, h = (i / 64) % 16, d = i / (64 * 16);
        const size_t ci = ((size_t)((d * 64 + g) * 16 + h)) * 64 + p; Cc[i * 2] = cre[ci]; Cc[i * 2 + 1] = cim[ci]; }
    __syncthreads();
    {
        const int h = F.tid % 16, l = (F.tid / 16) % 16, d = F.tid / 256; float s16[16];
#pragma unroll
        for (int hp = 0; hp < 16; ++hp) s16[hp] = 0.f;
#pragma unroll 2
        for (int p = 0; p < 64; ++p) { const f32x2 c2 = *(const f32x2*)(Cc + ((d * 16 + h) * 64 + p) * 2), a2 = *(const f32x2*)(Ap + ((d * 64 + p) * 17 + l) * 2);
            const float tr = c2.x * a2.x - c2.y * a2.y, ti = c2.x * a2.y + c2.y * a2.x; const float* bp = BB + ((d * 64 + p) * 16) * 2;
#pragma unroll
            for (int h4 = 0; h4 < 8; ++h4) { const f32x4 b = *(const f32x4*)(bp + 4 * h4); s16[2 * h4] += tr * b[0] - ti * b[1]; s16[2 * h4 + 1] += tr * b[2] - ti * b[3]; } }
#pragma unroll
        for (int h4 = 0; h4 < 4; ++h4) *(f32x4*)(Kt + ((d * 16 + l) * 16 + h) * 16 + 4 * h4) = (f32x4){s16[4 * h4], s16[4 * h4 + 1], s16[4 * h4 + 2], s16[4 * h4 + 3]}; }
    __syncthreads();
    bf16_t* Wt = (bf16_t*)(F.ws + WS_S5W) + (size_t)g * 256 * 256; bf16_t* Mg = (bf16_t*)(F.ws + WS_S5M) + (size_t)g * 256 * 512;
    for (int v = F.tid; v < 256 * 32; v += 512) { const int n = v >> 5, k0 = (v & 31) * 8; const int d = n >> 7, p = (n >> 1) & 63, ri = n & 1; const int s = k0 >> 4, h0 = k0 & 15, e = d ? s : 15 - s;
        const float ar = Ap[((d * 64 + p) * 17 + e) * 2], ai = Ap[((d * 64 + p) * 17 + e) * 2 + 1]; float o[8];
#pragma unroll
        for (int j = 0; j < 8; ++j) { const float br = BB[((d * 64 + p) * 16 + h0 + j) * 2], bi = BB[((d * 64 + p) * 16 + h0 + j) * 2 + 1]; o[j] = ri ? (ar * bi + ai * br) : (ar * br - ai * bi); }
        u32x4 w; w.x = pk2(o[0], o[1]); w.y = pk2(o[2], o[3]); w.z = pk2(o[4], o[5]); w.w = pk2(o[6], o[7]); *(u32x4*)(Wt + (size_t)n * 256 + k0) = w; }
    for (int v = F.tid; v < 256 * 64; v += 512) { const int n = v >> 6, k0 = (v & 63) * 8; const int t = n >> 4, h = n & 15; float o[8];
        if (k0 < 256) { const int s = k0 >> 4, h0 = k0 & 15;
#pragma unroll
            for (int j = 0; j < 8; ++j) { float x = 0.f; if (s <= t) x += Kt[((0 * 16 + (t - s)) * 16 + h) * 16 + h0 + j]; if (s >= t) x += Kt[((1 * 16 + (s - t)) * 16 + h) * 16 + h0 + j]; o[j] = x; }
        } else { const int d = (k0 - 256) >> 7, e = d ? 16 - t : t + 1;
#pragma unroll
            for (int j = 0; j < 8; ++j) { const int kk = (k0 - 256 - d * 128) + j, p = kk >> 1, ri = kk & 1;
                const float cr = Cc[((d * 16 + h) * 64 + p) * 2], ci = Cc[((d * 16 + h) * 64 + p) * 2 + 1]; const float ar = Ap[((d * 64 + p) * 17 + e) * 2], ai = Ap[((d * 64 + p) * 17 + e) * 2 + 1];
                o[j] = ri ? -(cr * ai + ci * ar) : (cr * ar - ci * ai); } }
        u32x4 w; w.x = pk2(o[0], o[1]); w.y = pk2(o[2], o[3]); w.z = pk2(o[4], o[5]); w.w = pk2(o[6], o[7]); *(u32x4*)(Mg + (size_t)n * 512 + k0) = w; }
    __syncthreads();
}

constexpr int J_IN = 32 * 193, J_OUT = 32 * 64, J_F13 = 32 * 176, J_F2 = 88 * 64, J_M13 = 32 * 224, J_M2 = 112 * 64;
constexpr int Q_L1 = J_IN + J_OUT, Q_ALL = Q_L1 + 16 * J_M13 + 8 * J_M2;
constexpr int TQ2 = 160, TQ9 = 160, TQ10 = 112, TQ12 = 160;
constexpr int TB2 = 0, TB9 = TB2 + 92 * TQ2, TB10 = TB9 + 80 * TQ9, TB12 = TB10 + 128 * TQ10, Q_HID = TB12 + 92 * TQ12;
static_assert(Q_L1 <= TB9 && Q_HID <= Q_ALL, "the layer-1 projection copies must be complete before phase 12");
__device__ __forceinline__ void deferred_item(Frame& F, int r, float* scr) {
    bf16_t* win1 = (bf16_t*)(F.ws + WS_WIN1); bf16_t* wout1 = (bf16_t*)(F.ws + WS_WOUT1); bf16_t* w13m = (bf16_t*)(F.ws + WS_W13M); bf16_t* w2m = (bf16_t*)(F.ws + WS_W2M);
    if (r < J_IN) { p0_transpose_item(F.ap->in[I_OWIN], D, EIN, win1, r / 193, 32 * (r % 193), 32 * (r % 193), scr, F.lane); return; } r -= J_IN;
    if (r < J_OUT) { p0_transpose_item(F.ap->in[I_OWOUT], D, D, wout1, r / 64, 32 * (r % 64), 32 * (r % 64), scr, F.lane); return; } r -= J_OUT;
    if (r < 8 * J_M13) { const int e = r / J_M13, q = r % J_M13, n0 = 32 * (q % 224); p0_transpose_item(F.ap->in[I_MW1] + (size_t)e * D * EXH, D, EXH, w13m + (size_t)e * 2 * EXH * D, q / 224, n0, il_row(n0, 0), scr, F.lane); return; } r -= 8 * J_M13;
    if (r < 8 * J_M13) { const int e = r / J_M13, q = r % J_M13, n0 = 32 * (q % 224); p0_transpose_item(F.ap->in[I_MW3] + (size_t)e * D * EXH, D, EXH, w13m + (size_t)e * 2 * EXH * D, q / 224, n0, il_row(n0, 1), scr, F.lane); return; } r -= 8 * J_M13;
    { const int e = r / J_M2, q = r % J_M2; p0_transpose_item(F.ap->in[I_MW2] + (size_t)e * EXH * D, EXH, D, w2m + (size_t)e * D * EXH, q / 64, 32 * (q % 64), 32 * (q % 64), scr, F.lane); }
}
__device__ __forceinline__ void tail_convert(Frame& F, int base, int per_wg, int rank) {
    if (rank < 0) return;
    float* scr = (float*)(F.ldsg + F.wave * 16384);
    for (int j = 0; j < per_wg; j += 8) deferred_item(F, base + rank * per_wg + j + F.wave, scr);
}
__device__ __forceinline__ void p0_prologue(Frame& F) {
    for (int it = F.bid; it < 256; it += F.G) { if (it < 192) p0_adaln_item(F, it); else p0_s5_item(F, it - 192); }
    __syncthreads();
    float* scr = (float*)(F.ldsg + F.wave * 16384);
    const int gw = F.bid * NWAVES + F.wave, NGW = F.G * NWAVES;
    constexpr int E0 = J_IN, E1 = E0 + J_OUT, E2 = E1 + J_F13, E3 = E2 + J_F13, E4 = E3 + J_F2;
    bf16_t* win0 = (bf16_t*)(F.ws + WS_WIN0); bf16_t* wout0 = (bf16_t*)(F.ws + WS_WOUT0); bf16_t* w130 = (bf16_t*)(F.ws + WS_W130); bf16_t* w20 = (bf16_t*)(F.ws + WS_W20);
    bf16_t* win1 = (bf16_t*)(F.ws + WS_WIN1);
    const int qbeg = (F.G == 256) ? Q_HID : 0;
    for (int it = gw; it < E4 + (Q_ALL - qbeg); it += NGW) {
        int r = it;
        if (r < E0) { p0_transpose_item(F.ap->in[I_EWIN], D, EIN, win0, r / 193, 32 * (r % 193), 32 * (r % 193), scr, F.lane); continue; }
        if (r < E1) { r -= E0; p0_transpose_item(F.ap->in[I_EWOUT], D, D, wout0, r / 64, 32 * (r % 64), 32 * (r % 64), scr, F.lane); continue; }
        if (r < E2) { r -= E1; const int n0 = 32 * (r % 176); p0_transpose_item(F.ap->in[I_FW1], D, FFH, w130, r / 176, n0, il_row(n0, 0), scr, F.lane); continue; }
        if (r < E3) { r -= E2; const int n0 = 32 * (r % 176); p0_transpose_item(F.ap->in[I_FW3], D, FFH, w130, r / 176, n0, il_row(n0, 1), scr, F.lane); continue; }
        if (r < E4) { r -= E3; p0_transpose_item(F.ap->in[I_FW2], FFH, D, w20, r / 64, 32 * (r % 64), 32 * (r % 64), scr, F.lane); continue; }
        deferred_item(F, qbeg + (r - E4), scr);
    }
    { float* RT = (float*)(F.ws + MOE_RT); const float* rw = F.ap->in[I_ROUTER]; for (int i = F.bid * 512 + F.tid; i < 8 * D; i += F.G * 512) RT[i] = rw[(i % D) * 8 + i / D]; }
    { const size_t nvec = (size_t)(EINP - EIN) * D / 8; const u32x4 z = {0u, 0u, 0u, 0u};
      for (size_t i = (size_t)F.bid * 512 + F.tid; i < 2 * nvec; i += (size_t)F.G * 512) { bf16_t* base = i < nvec ? win0 : win1; const size_t j = i < nvec ? i : i - nvec; *(u32x4*)(base + (size_t)EIN * D + j * 8) = z; } }
}

__device__ __forceinline__ void p1_modulate(Frame& F) {
    const int gw = F.bid * NWAVES + F.wave, NGW = F.G * NWAVES;
    const int r_beg = (int)(((long long)gw * MT) / NGW), r_end = (int)(((long long)(gw + 1) * MT) / NGW);
    const float* MOD = (const float*)(F.ws + WS_MOD); bf16_t* A0 = (bf16_t*)(F.ws + WS_A0);
    int l4 = 4 * F.lane; asm volatile("" : "+v"(l4));
    f32x4 S1[8], SH[8], v[8], vn[8]; int cur = -1;
    if (r_beg < r_end) { const float* src = r_beg < NL ? F.ap->in[I_X] + (size_t)r_beg * D : F.ap->in[I_CTX] + (size_t)(r_beg - NL) * D;
#pragma unroll
        for (int j = 0; j < 8; ++j) v[j] = *(const f32x4*)(src + l4 + 256 * j); }
#pragma unroll 1
    for (int r = r_beg; r < r_end; ++r) {
        const int mb = r < NL ? r >> 12 : 4;
        if (mb != cur) { const float* md = MOD + (size_t)mb * NMOD;
#pragma unroll
            for (int j = 0; j < 8; ++j) { SH[j] = *(const f32x4*)(md + l4 + 256 * j); S1[j] = *(const f32x4*)(md + 2048 + l4 + 256 * j) + 1.0f; }
            cur = mb; }
        { const int rn = r + 1 < r_end ? r + 1 : r; const float* src = rn < NL ? F.ap->in[I_X] + (size_t)rn * D : F.ap->in[I_CTX] + (size_t)(rn - NL) * D;
#pragma unroll
          for (int j = 0; j < 8; ++j) vn[j] = *(const f32x4*)(src + l4 + 256 * j); }
#pragma unroll
        for (int j = 0; j < 8; ++j) { const f32x4 y = v[j] * S1[j] + SH[j]; u32x2 w; w.x = pk2(y[0], y[1]); w.y = pk2(y[2], y[3]); *(u32x2*)(A0 + (size_t)r * D + l4 + 256 * j) = w; }
#pragma unroll
        for (int j = 0; j < 8; ++j) v[j] = vn[j];
    }
}
__device__ __forceinline__ void row_stats(const f32x4 (&v)[8], float& mean, float& rstd) {
    float s = 0.f;
#pragma unroll
    for (int j = 0; j < 8; ++j) s += (v[j][0] + v[j][1]) + (v[j][2] + v[j][3]);
    mean = wave_sum(s) * (1.f / D); float q = 0.f;
#pragma unroll
    for (int j = 0; j < 8; ++j) { const f32x4 d = v[j] - mean; q += (d[0] * d[0] + d[1] * d[1]) + (d[2] * d[2] + d[3] * d[3]); }
    rstd = 1.0f / sqrtf(wave_sum(q) * (1.f / D) + EPS);
}
__device__ __forceinline__ void ln_pq(const float* lg, const float* lb, const float* mdsh, const float* mdsc, int l4, f32x4 (&P)[8], f32x4 (&Q)[8]) {
#pragma unroll
    for (int j = 0; j < 8; ++j) { const int c = l4 + 256 * j; const f32x4 gg = *(const f32x4*)(lg + c), bb = *(const f32x4*)(lb + c), sh = *(const f32x4*)(mdsh + c), sc = *(const f32x4*)(mdsc + c) + 1.0f;
        P[j] = gg * sc; Q[j] = bb * sc + sh; }
}
__device__ __forceinline__ void ln_mod_rows(Frame& F, int nrows, const float* lg, const float* lb, int modlayer, int shk, int sck, bf16_t* Aout) {
    const int gw = F.bid * NWAVES + F.wave, NGW = F.G * NWAVES;
    const int r_beg = (int)(((long long)gw * nrows) / NGW), r_end = (int)(((long long)(gw + 1) * nrows) / NGW);
    const float* MOD = (const float*)(F.ws + WS_MOD) + (size_t)modlayer * 5 * NMOD; const bf16_t* XR = (const bf16_t*)(F.ws + WS_XR);
    int l4 = 4 * F.lane; asm volatile("" : "+v"(l4));
    f32x4 P[8], Q[8], v[8]; u32x2 vn[8]; int cur = -1;
    if (r_beg < r_end) {
#pragma unroll
        for (int j = 0; j < 8; ++j) v[j] = pg8::res_cvt(*(const u32x2*)(XR + (size_t)r_beg * D + l4 + 256 * j));
    }
#pragma unroll 1
    for (int r = r_beg; r < r_end; ++r) {
        const int mb = r < NL ? r >> 12 : 4;
        if (mb != cur) { const float* md = MOD + (size_t)mb * NMOD; ln_pq(lg, lb, md + shk * 2048, md + sck * 2048, l4, P, Q); cur = mb; }
        { const int rn = r + 1 < r_end ? r + 1 : r; const bf16_t* xn = XR + (size_t)rn * D;
#pragma unroll
          for (int j = 0; j < 8; ++j) vn[j] = *(const u32x2*)(xn + l4 + 256 * j); }
        float mean, rstd; row_stats(v, mean, rstd);
        if (F.lane == 0) *(f32x2*)((float*)(F.ws + MOE_STATS) + (size_t)r * 2) = (f32x2){mean, rstd};
#pragma unroll
        for (int j = 0; j < 8; ++j) { const f32x4 t = (v[j] - mean) * rstd * P[j] + Q[j];
            u32x2 w; w.x = pk2(t[0], t[1]); w.y = pk2(t[2], t[3]); *(u32x2*)(Aout + (size_t)r * D + l4 + 256 * j) = w; }
#pragma unroll
        for (int j = 0; j < 8; ++j) v[j] = pg8::res_cvt(vn[j]);
    }
}

struct CvWin { u32x2 x[3][6]; };
__device__ __forceinline__ void cv_load(CvWin& wdw, const unsigned char* P, int b, int n, bool isctx, int R, int c0, unsigned lo) {
#pragma unroll
    for (int i = 0; i < 3; ++i)
#pragma unroll
        for (int cc = 0; cc < 6; ++cc) { const int col = c0 + cc - 1; int row = -1;
            if (isctx) { const int t = 64 * n + col; if (i == 1 && t >= 0 && t < CTXL) row = NL + b * CTXL + t; }
            else { const int Rr = R + i - 1; if (Rr >= 0 && Rr < 64 && col >= 0 && col < 64) row = b * SEQ + Rr * 64 + col; }
            u32x2 v = {0u, 0u}; if (row >= 0) v = *(const u32x2*)(P + (size_t)row * (EINP * 2) + lo);
            wdw.x[i][cc] = v; }
}
__device__ __forceinline__ void cv_compute(const CvWin& wdw, const float (&wt)[3][3][4], unsigned char* Q, int row0, int c0, unsigned lo, bool norm, float qs) {
#pragma unroll
    for (int cc = 0; cc < 4; ++cc) { float y0 = 0.f, y1 = 0.f, y2 = 0.f, y3 = 0.f;
#pragma unroll
        for (int i = 0; i < 3; ++i)
#pragma unroll
            for (int j = 0; j < 3; ++j) { const u32x2 x = wdw.x[i][cc + j]; y0 += bflo(x.x) * wt[i][j][0]; y1 += bfhi(x.x) * wt[i][j][1]; y2 += bflo(x.y) * wt[i][j][2]; y3 += bfhi(x.y) * wt[i][j][3]; }
        y0 = siluf_(y0); y1 = siluf_(y1); y2 = siluf_(y2); y3 = siluf_(y3);
        if (norm) { float ss = (y0 * y0 + y1 * y1) + (y2 * y2 + y3 * y3); ss += __shfl_xor(ss, 1); ss += __shfl_xor(ss, 2); ss += __shfl_xor(ss, 4); ss += __shfl_xor(ss, 8); ss += __shfl_xor(ss, 16);
            const float sc = qs * __builtin_amdgcn_rsqf(ss + EPS); y0 *= sc; y1 *= sc; y2 *= sc; y3 *= sc; }
        u32x2 o; o.x = pk2(y0, y1); o.y = pk2(y2, y3);
        *(u32x2*)(Q + (size_t)(row0 + c0 + cc) * (3072 * 2) + lo) = o; }
}
struct CvItem { int b, n, R, row0, ch; unsigned lo; bool isctx, norm; float qs; };
__device__ __forceinline__ void cv_decode(int it, int lane, CvItem& I) {
    const int g12 = it % 12, seg = it / 12; I.b = seg / NCH; I.n = seg % NCH; I.isctx = I.n < 4; I.R = I.n - 4;
    I.ch = g12 * 256 + 4 * lane; I.lo = (unsigned)(I.ch * 2); I.qs = g12 < 4 ? 0.08838834764831845f : 1.0f; I.norm = g12 < 8;
    I.row0 = I.isctx ? NL + I.b * CTXL + 64 * I.n : I.b * SEQ + I.R * 64;
}
__device__ __forceinline__ void cv_weights(const float* cw, int ch, float (&wt)[3][3][4]) {
#pragma unroll
    for (int i = 0; i < 3; ++i)
#pragma unroll
        for (int j = 0; j < 3; ++j) { const f32x4 a0 = *(const f32x4*)(cw + (i * 3 + j) * 3072 + ch); wt[i][j][0] = a0[0]; wt[i][j][1] = a0[1]; wt[i][j][2] = a0[2]; wt[i][j][3] = a0[3]; }
}
__device__ __forceinline__ void p3_dn_conv(Frame& F) {
    const int gw = F.bid * NWAVES + F.wave, NGW = F.G * NWAVES;
    const float* cw = F.ap->in[I_DNCONV];
    const unsigned char* P = F.ws + WS_P; unsigned char* Q = F.ws + WS_QKVN;
    constexpr int NB4 = 272 * 12 * 16;
    int s_beg = (int)(((long long)gw * NB4) / NGW), s_end = (int)(((long long)(gw + 1) * NB4) / NGW);
    if (F.G == 256) {
        const int w = (int)F.bid; const int hb = w < 64 ? 363 * w : 23232 + 423 * (w - 64), he = w < 64 ? 363 * (w + 1) : 23232 + 423 * (w - 63);
        const int wb_ = hb >> 1, we_ = he >> 1; s_beg = wb_ + (we_ - wb_) * F.wave / 8; s_end = wb_ + (we_ - wb_) * (F.wave + 1) / 8; }
    if (s_beg >= s_end) return;
    float wt[3][3][4]; int cur = -1;
    CvItem IA, IB; CvWin wa, wb;
    cv_decode(s_beg >> 4, F.lane, IA); cv_load(wa, P, IA.b, IA.n, IA.isctx, IA.R, 4 * (s_beg & 15), IA.lo);
#pragma unroll 1
    for (int s0 = s_beg; s0 < s_end; s0 += 2) {
        { const int s1 = s0 + 1 < s_end ? s0 + 1 : s0; cv_decode(s1 >> 4, F.lane, IB); cv_load(wb, P, IB.b, IB.n, IB.isctx, IB.R, 4 * (s1 & 15), IB.lo); }
        if ((s0 >> 4) != cur) { cur = s0 >> 4; cv_weights(cw, IA.ch, wt); }
        cv_compute(wa, wt, Q, IA.row0, 4 * (s0 & 15), IA.lo, IA.norm, IA.qs);
        { const int s2 = s0 + 2 < s_end ? s0 + 2 : s0; cv_decode(s2 >> 4, F.lane, IA); cv_load(wa, P, IA.b, IA.n, IA.isctx, IA.R, 4 * (s2 & 15), IA.lo); }
        if (s0 + 1 < s_end) {
            if (((s0 + 1) >> 4) != cur) { cur = (s0 + 1) >> 4; cv_weights(cw, IB.ch, wt); }
            cv_compute(wb, wt, Q, IB.row0, 4 * ((s0 + 1) & 15), IB.lo, IB.norm, IB.qs); }
    }
}

#define WG_BAR() do { asm volatile("s_waitcnt lgkmcnt(0)" ::: "memory"); __builtin_amdgcn_s_barrier(); asm volatile("" ::: "memory"); } while (0)
struct DnIn { u32x4 q[4], k[4], v[4]; float bt, a; };
__device__ __forceinline__ void dnp_load(DnIn& in, Frame& F, int pair, int sub, int ts) {
    const bf16_t* P = (const bf16_t*)(F.ws + WS_P); const bf16_t* Q = (const bf16_t*)(F.ws + WS_QKVN);
    const int item = pair * 2 + sub; const int n = item % NCH, chain = item / NCH, d = chain & 1, h = (chain >> 1) & 7, b = chain >> 4;
#pragma unroll
    for (int j = 0; j < 4; ++j) { const int cidx = ts + 256 * j, i = cidx >> 4, cc = cidx & 15; const bf16_t* src = Q + (size_t)tok_row(b, d, n, i) * 3072 + h * 128 + cc * 8;
        in.q[j] = *(const u32x4*)src; in.k[j] = *(const u32x4*)(src + 1024); in.v[j] = *(const u32x4*)(src + 2048); }
    if (ts < 64) { const int r = tok_row(b, d, n, ts); in.bt = bf1(P[(size_t)r * EINP + 6144 + d * 8 + h]); in.a = bf1(P[(size_t)r * EINP + 6160 + d * 8 + h]); }
}
__device__ __forceinline__ void p4_dn_prep(Frame& F) {
    const int sub = F.tid >> 8, ts = F.tid & 255, ws4 = F.wave & 3, lane = F.lane;
    unsigned char* base = F.ldsg + sub * 69632;
    bf16_t* kL = (bf16_t*)base;
    bf16_t* qL = (bf16_t*)(base + 17408);
    bf16_t* vL = (bf16_t*)(base + 34816);
    float* Lm = (float*)(base + 52224);
    float* sm = (float*)(base + 68608);
    DnIn in;
    if (F.bid < 2176) dnp_load(in, F, F.bid, sub, ts);
#pragma unroll 1
    for (int pair = F.bid; pair < 2176; pair += F.G) {
        const int item = pair * 2 + sub; const int n = item % NCH, chain = item / NCH, d = chain & 1, h = (chain >> 1) & 7;
        unsigned char* ob = F.ws + WS_DNB + (size_t)item * DN_STRIDE;
#pragma unroll
        for (int j = 0; j < 4; ++j) { const int cidx = ts + 256 * j, i = cidx >> 4, cc = cidx & 15; *(u32x4*)(qL + i * 136 + cc * 8) = in.q[j]; *(u32x4*)(kL + i * 136 + cc * 8) = in.k[j]; *(u32x4*)(vL + i * 136 + cc * 8) = in.v[j]; }
        if (ws4 == 0) { const float bt = sigmoidf_(in.bt);
            float gv = -__expf(F.ap->in[I_DNALOG][d * 8 + h]) * softplusf_(in.a + F.ap->in[I_DNDT][d * 8 + h]);
#pragma unroll
            for (int o = 1; o < 64; o <<= 1) { const float t = __shfl_up(gv, o); if (lane >= o) gv += t; }
            sm[lane] = bt; sm[64 + lane] = gv; sm[128 + lane] = __expf(gv); }
        WG_BAR();
        for (int tix = ws4; tix < 10; tix += 4) { const int it = tix >= 6 ? 3 : tix >= 3 ? 2 : tix >= 1 ? 1 : 0, jt = tix - it * (it + 1) / 2;
            f32x4 ak = {0.f, 0.f, 0.f, 0.f}, aq = {0.f, 0.f, 0.f, 0.f};
#pragma unroll
            for (int kk = 0; kk < 4; ++kk) { const bf16x8 fa = *(const bf16x8*)(kL + (16 * jt + (lane & 15)) * 136 + 32 * kk + 8 * (lane >> 4));
                const bf16x8 fk = *(const bf16x8*)(kL + (16 * it + (lane & 15)) * 136 + 32 * kk + 8 * (lane >> 4)); const bf16x8 fq_ = *(const bf16x8*)(qL + (16 * it + (lane & 15)) * 136 + 32 * kk + 8 * (lane >> 4));
                ak = __builtin_amdgcn_mfma_f32_16x16x32_bf16(fa, fk, ak, 0, 0, 0); aq = __builtin_amdgcn_mfma_f32_16x16x32_bf16(fa, fq_, aq, 0, 0, 0); }
            const int i = 16 * it + (lane & 15), j0 = 16 * jt + 4 * (lane >> 4); const float bi = sm[i], gi = sm[64 + i];
            f32x4 lv; float av[4];
#pragma unroll
            for (int q = 0; q < 4; ++q) { const int j = j0 + q; const float dec = __expf(gi - sm[64 + j]); lv[q] = (i > j) ? bi * ak[q] * dec : 0.f; av[q] = (i >= j) ? aq[q] * dec : 0.f; }
            Lm[(j0 + 0) * 64 + i] = lv[0]; Lm[(j0 + 1) * 64 + i] = lv[1]; Lm[(j0 + 2) * 64 + i] = lv[2]; Lm[(j0 + 3) * 64 + i] = lv[3];
            u32x2 w; w.x = pk2(av[0], av[1]); w.y = pk2(av[2], av[3]); *(u32x2*)(ob + DN_ATT + (size_t)(i * 64 + j0) * 2) = w; }
        {
            const int it = ws4; const u32x2 z = {0u, 0u};
            for (int jt = it + 1; jt < 4; ++jt) { const int i = 16 * it + (lane & 15), j0 = 16 * jt + 4 * (lane >> 4); *(u32x2*)(ob + DN_ATT + (size_t)(i * 64 + j0) * 2) = z; } }
        WG_BAR();
        f32x2 sp[32];
        if (ts < 128) {
#pragma unroll
            for (int m = 0; m < 32; ++m) sp[m] = (f32x2){bf1(vL[(2 * m) * 136 + ts]) * sm[2 * m], bf1(vL[(2 * m + 1) * 136 + ts]) * sm[2 * m + 1]};
        } else {
#pragma unroll
            for (int m = 0; m < 32; ++m) sp[m] = (f32x2){bf1(kL[(2 * m) * 136 + ts - 128]) * sm[2 * m] * sm[128 + 2 * m], bf1(kL[(2 * m + 1) * 136 + ts - 128]) * sm[2 * m + 1] * sm[128 + 2 * m + 1]};
        }
        {
#pragma unroll
            for (int j = 0; j < 63; ++j) { f32x4 Lr[16];
#pragma unroll
                for (int g = (j + 1) / 4; g < 16; ++g) Lr[g] = *(const f32x4*)(Lm + j * 64 + 4 * g);
                __builtin_amdgcn_sched_barrier(0);
                const float sj = (j & 1) ? sp[j >> 1].y : sp[j >> 1].x; const f32x2 s2 = {sj, sj};
#pragma unroll
                for (int g = (j + 1) / 4; g < 16; ++g) {
                    if (4 * g + 1 > j) sp[2 * g] -= (f32x2){Lr[g][0], Lr[g][1]} * s2;
                    if (4 * g + 3 > j) sp[2 * g + 1] -= (f32x2){Lr[g][2], Lr[g][3]} * s2; }
                __builtin_amdgcn_sched_barrier(0); }
        }
        float sol[64];
#pragma unroll
        for (int m = 0; m < 32; ++m) { sol[2 * m] = sp[m].x; sol[2 * m + 1] = sp[m].y; }
        if (ts < 128) {
#pragma unroll
            for (int i8 = 0; i8 < 8; ++i8) { u32x4 w; w.x = pk2(sol[8 * i8], sol[8 * i8 + 1]); w.y = pk2(sol[8 * i8 + 2], sol[8 * i8 + 3]); w.z = pk2(sol[8 * i8 + 4], sol[8 * i8 + 5]); w.w = pk2(sol[8 * i8 + 6], sol[8 * i8 + 7]);
                *(u32x4*)(ob + DN_UT + (size_t)(ts * 64 + 8 * i8) * 2) = w; }
        }
        if (pair + F.G < 2176) dnp_load(in, F, pair + F.G, sub, ts);
#pragma unroll
        for (int j = 0; j < 4; ++j) { const int cidx = ts + 256 * j, i = cidx >> 4, cc = cidx & 15; const u32x4 qv = *(const u32x4*)(qL + i * 136 + cc * 8); const float e = sm[128 + i];
            u32x4 w; w.x = pk2(bflo(qv.x) * e, bfhi(qv.x) * e); w.y = pk2(bflo(qv.y) * e, bfhi(qv.y) * e); w.z = pk2(bflo(qv.z) * e, bfhi(qv.z) * e); w.w = pk2(bflo(qv.w) * e, bfhi(qv.w) * e);
            *(u32x4*)(ob + DN_QG + (size_t)(i * 128 + cc * 8) * 2) = w; }
        WG_BAR();
        if (ts >= 128) {
#pragma unroll
            for (int i = 0; i < 64; ++i) qL[i * 136 + ts - 128] = (bf16_t)f2bf(sol[i]);
        }
        unsigned char* KS = (unsigned char*)Lm;
        { const int dk = ts & 127, ih = ts >> 7; const float gl = sm[64 + 63];
#pragma unroll
          for (int i8 = 0; i8 < 4; ++i8) { float o[8];
#pragma unroll
              for (int q = 0; q < 8; ++q) { const int i = 32 * ih + 8 * i8 + q; o[q] = bf1(kL[i * 136 + dk]) * __expf(gl - sm[64 + i]); }
              u32x4 w; w.x = pk2(o[0], o[1]); w.y = pk2(o[2], o[3]); w.z = pk2(o[4], o[5]); w.w = pk2(o[6], o[7]);
              *(u32x4*)(KS + dk * 128 + 16 * ((4 * ih + i8) ^ (dk & 7))) = w; }
          if (ts == 0) *(float*)(ob + DN_GL) = __expf(gl); }
        WG_BAR();
#pragma unroll
        for (int j = 0; j < 4; ++j) { const int cidx = ts + 256 * j, i = cidx >> 4, cc = cidx & 15; *(u32x4*)(ob + DN_W + (size_t)(i * 128 + cc * 8) * 2) = *(const u32x4*)(qL + i * 136 + cc * 8);
            const int r = cidx >> 3, p = cidx & 7; *(u32x4*)(ob + DN_KGT + (size_t)(r * 64 + 8 * p) * 2) = *(const u32x4*)(KS + r * 128 + 16 * (p ^ (r & 7))); }
        WG_BAR();
    }
}

constexpr int DN_LVT = 17408, DN_OB = 26624, DN_OBP = 68, DN_LW = 61440, DN_LQG = 78848, DN_LAT = 96256, DN_LKG = 105472, DN_LUT = 123904;
struct DnStage { u32x4 w[2], qg[2], kg[2], at, ut; float gl; };
__device__ __forceinline__ void dn_stage_load(DnStage& st, const unsigned char* ib, int sl, int tid) {
    const unsigned o = (unsigned)tid * 16u;
    st.gl = *(const float*)(ib + DN_GL);
#pragma unroll
    for (int j = 0; j < 2; ++j) { st.w[j] = *(const u32x4*)(ib + DN_W + 8192 * j + o); st.qg[j] = *(const u32x4*)(ib + DN_QG + 8192 * j + o); st.kg[j] = *(const u32x4*)(ib + DN_KGT + 8192 * j + o); }
    st.at = *(const u32x4*)(ib + DN_ATT + o);
    st.ut = *(const u32x4*)(ib + DN_UT + 8192 * sl + o);
}
__device__ __forceinline__ void dn_stage_store(const DnStage& st, unsigned char* lds, int tid) {
#pragma unroll
    for (int j = 0; j < 2; ++j) { const int cidx = tid + 512 * j; *(u32x4*)(lds + DN_LW + (cidx >> 4) * 272 + (cidx & 15) * 16) = st.w[j]; *(u32x4*)(lds + DN_LQG + (cidx >> 4) * 272 + (cidx & 15) * 16) = st.qg[j];
        *(u32x4*)(lds + DN_LKG + (cidx >> 3) * 144 + (cidx & 7) * 16) = st.kg[j]; }
    *(u32x4*)(lds + DN_LAT + (tid >> 3) * 144 + (tid & 7) * 16) = st.at;
    *(u32x4*)(lds + DN_LUT + (tid >> 3) * 144 + (tid & 7) * 16) = st.ut;
}
__device__ __forceinline__ void dn_flush(Frame& F, int nlast, int b, int d, int h, int sl) {
    const float* Ob = (const float*)(F.ldsg + DN_OB); bf16_t* O = (bf16_t*)(F.ws + WS_ODN);
#pragma unroll
    for (int j = 0; j < 2; ++j) { const int idx = F.tid + 512 * j, c8 = idx & 7, pos = (idx >> 3) & 63, sn = idx >> 9;
        const f32x4 v0 = *(const f32x4*)(Ob + (sn * 64 + pos) * DN_OBP + 8 * c8), v1 = *(const f32x4*)(Ob + (sn * 64 + pos) * DN_OBP + 8 * c8 + 4); const int r = tok_row(b, d, nlast - 1 + sn, pos);
        u32x4 w; w.x = pk2(v0[0], v0[1]); w.y = pk2(v0[2], v0[3]); w.z = pk2(v1[0], v1[1]); w.w = pk2(v1[2], v1[3]);
        *(u32x4*)(O + ((size_t)d * MT + r) * 1024 + h * 128 + 64 * sl + 8 * c8) = w; }
}
__device__ __forceinline__ void p5_dn_scan(Frame& F, int G2, int c2) {
    unsigned char* L = F.ldsg; bf16_t* St = (bf16_t*)L; bf16_t* Vt = (bf16_t*)(L + DN_LVT); float* Ob = (float*)(L + DN_OB);
    const int w = F.wave, lr = F.lane & 15, lq = F.lane >> 4, pt = w >> 1, cth = w & 1;
    for (int unit = c2; unit < 128; unit += G2) {
        const int sl = unit & 1, chain = unit >> 1, d = chain & 1, h = (chain >> 1) & 7, b = chain >> 4;
        f32x4 accS[4];
#pragma unroll
        for (int c4 = 0; c4 < 4; ++c4) accS[c4] = (f32x4){0.f, 0.f, 0.f, 0.f};
        for (int i = F.tid; i < 17408 / 4; i += 512) ((unsigned*)St)[i] = 0u;
        const unsigned char* ib0 = F.ws + WS_DNB + (size_t)(chain * NCH) * DN_STRIDE;
        DnStage sgA, sgB; dn_stage_load(sgA, ib0, sl, F.tid); dn_stage_load(sgB, ib0 + DN_STRIDE, sl, F.tid);
#pragma unroll 1
        for (int t = 0; t < NCH; t += 2) {
            {
            const float gl = sgA.gl;
            dn_stage_store(sgA, L, F.tid);
            if (t && (t & 1) == 0) dn_flush(F, t - 1, b, d, h, sl);
            dn_stage_load(sgA, ib0 + (size_t)(t + 2 < NCH ? t + 2 : NCH - 1) * DN_STRIDE, sl, F.tid);
            WG_BAR();
            f32x4 aw[2] = {{0.f, 0.f, 0.f, 0.f}, {0.f, 0.f, 0.f, 0.f}}, ao[2] = {{0.f, 0.f, 0.f, 0.f}, {0.f, 0.f, 0.f, 0.f}};
#pragma unroll
            for (int kk = 0; kk < 4; ++kk) { const bf16x8 fw = *(const bf16x8*)(L + DN_LW + (16 * pt + lr) * 272 + 64 * kk + 16 * lq), fqg = *(const bf16x8*)(L + DN_LQG + (16 * pt + lr) * 272 + 64 * kk + 16 * lq);
#pragma unroll
                for (int c2i = 0; c2i < 2; ++c2i) { const bf16x8 fs = *(const bf16x8*)(St + (16 * (2 * cth + c2i) + lr) * 136 + 32 * kk + 8 * lq);
                    aw[c2i] = __builtin_amdgcn_mfma_f32_16x16x32_bf16(fw, fs, aw[c2i], 0, 0, 0); ao[c2i] = __builtin_amdgcn_mfma_f32_16x16x32_bf16(fqg, fs, ao[c2i], 0, 0, 0); } }
#pragma unroll
            for (int c2i = 0; c2i < 2; ++c2i) { const int ct = 2 * cth + c2i; const u32x2 uu = *(const u32x2*)(L + DN_LUT + (16 * ct + lr) * 144 + (16 * pt + 4 * lq) * 2);
                const float v0 = bflo(uu.x) - aw[c2i][0], v1 = bfhi(uu.x) - aw[c2i][1], v2 = bflo(uu.y) - aw[c2i][2], v3 = bfhi(uu.y) - aw[c2i][3];
                u32x2 vv; vv.x = pk2(v0, v1); vv.y = pk2(v2, v3); *(u32x2*)(Vt + (16 * ct + lr) * 72 + 16 * pt + 4 * lq) = vv; }
            WG_BAR();
            bf16x8 fv[4][2];
#pragma unroll
            for (int c4 = 0; c4 < 4; ++c4)
#pragma unroll
                for (int kk = 0; kk < 2; ++kk) fv[c4][kk] = *(const bf16x8*)(Vt + (16 * c4 + lr) * 72 + 32 * kk + 8 * lq);
#pragma unroll
            for (int kk = 0; kk < 2; ++kk) { const bf16x8 fat = *(const bf16x8*)(L + DN_LAT + (16 * pt + lr) * 144 + 64 * kk + 16 * lq);
#pragma unroll
                for (int c2i = 0; c2i < 2; ++c2i) { const bf16x8 fb = *(const bf16x8*)(Vt + (16 * (2 * cth + c2i) + lr) * 72 + 32 * kk + 8 * lq); ao[c2i] = __builtin_amdgcn_mfma_f32_16x16x32_bf16(fat, fb, ao[c2i], 0, 0, 0); } }
            { bf16x8 fkg[2];
#pragma unroll
              for (int kk = 0; kk < 2; ++kk) fkg[kk] = *(const bf16x8*)(L + DN_LKG + (16 * w + lr) * 144 + 64 * kk + 16 * lq);
#pragma unroll
              for (int c4 = 0; c4 < 4; ++c4) { accS[c4] = accS[c4] * gl;
#pragma unroll
                  for (int kk = 0; kk < 2; ++kk) accS[c4] = __builtin_amdgcn_mfma_f32_16x16x32_bf16(fkg[kk], fv[c4][kk], accS[c4], 0, 0, 0);
                  u32x2 sv; sv.x = pk2(accS[c4][0], accS[c4][1]); sv.y = pk2(accS[c4][2], accS[c4][3]); *(u32x2*)(St + (16 * c4 + lr) * 136 + 16 * w + 4 * lq) = sv; } }
#pragma unroll
            for (int c2i = 0; c2i < 2; ++c2i)
#pragma unroll
                for (int q = 0; q < 4; ++q) Ob[((t & 1) * 64 + 16 * pt + 4 * lq + q) * DN_OBP + 16 * (2 * cth + c2i) + lr] = ao[c2i][q];
            WG_BAR();
            }
            {
            const float gl = sgB.gl;
            dn_stage_store(sgB, L, F.tid);
            if ((t + 1) && ((t + 1) & 1) == 0) dn_flush(F, (t + 1) - 1, b, d, h, sl);
            dn_stage_load(sgB, ib0 + (size_t)((t + 1) + 2 < NCH ? (t + 1) + 2 : NCH - 1) * DN_STRIDE, sl, F.tid);
            WG_BAR();
            f32x4 aw[2] = {{0.f, 0.f, 0.f, 0.f}, {0.f, 0.f, 0.f, 0.f}}, ao[2] = {{0.f, 0.f, 0.f, 0.f}, {0.f, 0.f, 0.f, 0.f}};
#pragma unroll
            for (int kk = 0; kk < 4; ++kk) { const bf16x8 fw = *(const bf16x8*)(L + DN_LW + (16 * pt + lr) * 272 + 64 * kk + 16 * lq), fqg = *(const bf16x8*)(L + DN_LQG + (16 * pt + lr) * 272 + 64 * kk + 16 * lq);
#pragma unroll
                for (int c2i = 0; c2i < 2; ++c2i) { const bf16x8 fs = *(const bf16x8*)(St + (16 * (2 * cth + c2i) + lr) * 136 + 32 * kk + 8 * lq);
                    aw[c2i] = __builtin_amdgcn_mfma_f32_16x16x32_bf16(fw, fs, aw[c2i], 0, 0, 0); ao[c2i] = __builtin_amdgcn_mfma_f32_16x16x32_bf16(fqg, fs, ao[c2i], 0, 0, 0); } }
#pragma unroll
            for (int c2i = 0; c2i < 2; ++c2i) { const int ct = 2 * cth + c2i; const u32x2 uu = *(const u32x2*)(L + DN_LUT + (16 * ct + lr) * 144 + (16 * pt + 4 * lq) * 2);
                const float v0 = bflo(uu.x) - aw[c2i][0], v1 = bfhi(uu.x) - aw[c2i][1], v2 = bflo(uu.y) - aw[c2i][2], v3 = bfhi(uu.y) - aw[c2i][3];
                u32x2 vv; vv.x = pk2(v0, v1); vv.y = pk2(v2, v3); *(u32x2*)(Vt + (16 * ct + lr) * 72 + 16 * pt + 4 * lq) = vv; }
            WG_BAR();
            bf16x8 fv[4][2];
#pragma unroll
            for (int c4 = 0; c4 < 4; ++c4)
#pragma unroll
                for (int kk = 0; kk < 2; ++kk) fv[c4][kk] = *(const bf16x8*)(Vt + (16 * c4 + lr) * 72 + 32 * kk + 8 * lq);
#pragma unroll
            for (int kk = 0; kk < 2; ++kk) { const bf16x8 fat = *(const bf16x8*)(L + DN_LAT + (16 * pt + lr) * 144 + 64 * kk + 16 * lq);
#pragma unroll
                for (int c2i = 0; c2i < 2; ++c2i) { const bf16x8 fb = *(const bf16x8*)(Vt + (16 * (2 * cth + c2i) + lr) * 72 + 32 * kk + 8 * lq); ao[c2i] = __builtin_amdgcn_mfma_f32_16x16x32_bf16(fat, fb, ao[c2i], 0, 0, 0); } }
            { bf16x8 fkg[2];
#pragma unroll
              for (int kk = 0; kk < 2; ++kk) fkg[kk] = *(const bf16x8*)(L + DN_LKG + (16 * w + lr) * 144 + 64 * kk + 16 * lq);
#pragma unroll
              for (int c4 = 0; c4 < 4; ++c4) { accS[c4] = accS[c4] * gl;
#pragma unroll
                  for (int kk = 0; kk < 2; ++kk) accS[c4] = __builtin_amdgcn_mfma_f32_16x16x32_bf16(fkg[kk], fv[c4][kk], accS[c4], 0, 0, 0);
                  u32x2 sv; sv.x = pk2(accS[c4][0], accS[c4][1]); sv.y = pk2(accS[c4][2], accS[c4][3]); *(u32x2*)(St + (16 * c4 + lr) * 136 + 16 * w + 4 * lq) = sv; } }
#pragma unroll
            for (int c2i = 0; c2i < 2; ++c2i)
#pragma unroll
                for (int q = 0; q < 4; ++q) Ob[(((t + 1) & 1) * 64 + 16 * pt + 4 * lq + q) * DN_OBP + 16 * (2 * cth + c2i) + lr] = ao[c2i][q];
            WG_BAR();
            }
        }
        dn_flush(F, NCH - 1, b, d, h, sl);
        WG_BAR();
    }
}
__device__ __forceinline__ void p6_dn_post(Frame& F) {
    const int gw = F.bid * NWAVES + F.wave, NGW = F.G * NWAVES;
    const int r_beg = (int)(((long long)gw * MT) / NGW), r_end = (int)(((long long)(gw + 1) * MT) / NGW);
    const bf16_t* O = (const bf16_t*)(F.ws + WS_ODN); const bf16_t* P = (const bf16_t*)(F.ws + WS_P); bf16_t* A1 = (bf16_t*)(F.ws + WS_A1); const float* nw = F.ap->in[I_DNNORM];
    int c0 = 16 * F.lane; asm volatile("" : "+v"(c0));
    float nwr[16];
#pragma unroll
    for (int q = 0; q < 16; ++q) nwr[q] = nw[(c0 + q) & 127];
    u32x4 a[2], bq[2], zv[2], an[2], bn[2], zn[2];
    if (r_beg < r_end) {
#pragma unroll
        for (int j = 0; j < 2; ++j) { a[j] = *(const u32x4*)(O + (size_t)r_beg * 1024 + c0 + 8 * j); bq[j] = *(const u32x4*)(O + ((size_t)MT + r_beg) * 1024 + c0 + 8 * j); zv[j] = *(const u32x4*)(P + (size_t)r_beg * EINP + 3072 + c0 + 8 * j); }
    }
#pragma unroll 1
    for (int r = r_beg; r < r_end; ++r) {
        { const int rn = r + 1 < r_end ? r + 1 : r;
#pragma unroll
          for (int j = 0; j < 2; ++j) { an[j] = *(const u32x4*)(O + (size_t)rn * 1024 + c0 + 8 * j); bn[j] = *(const u32x4*)(O + ((size_t)MT + rn) * 1024 + c0 + 8 * j); zn[j] = *(const u32x4*)(P + (size_t)rn * EINP + 3072 + c0 + 8 * j); } }
        float o[16], z[16]; float ss = 0.f;
#pragma unroll
        for (int j = 0; j < 2; ++j) {
            o[8 * j + 0] = bflo(a[j].x) + bflo(bq[j].x); o[8 * j + 1] = bfhi(a[j].x) + bfhi(bq[j].x); o[8 * j + 2] = bflo(a[j].y) + bflo(bq[j].y); o[8 * j + 3] = bfhi(a[j].y) + bfhi(bq[j].y);
            o[8 * j + 4] = bflo(a[j].z) + bflo(bq[j].z); o[8 * j + 5] = bfhi(a[j].z) + bfhi(bq[j].z); o[8 * j + 6] = bflo(a[j].w) + bflo(bq[j].w); o[8 * j + 7] = bfhi(a[j].w) + bfhi(bq[j].w);
            z[8 * j + 0] = bflo(zv[j].x); z[8 * j + 1] = bfhi(zv[j].x); z[8 * j + 2] = bflo(zv[j].y); z[8 * j + 3] = bfhi(zv[j].y); z[8 * j + 4] = bflo(zv[j].z); z[8 * j + 5] = bfhi(zv[j].z); z[8 * j + 6] = bflo(zv[j].w); z[8 * j + 7] = bfhi(zv[j].w); }
#pragma unroll
        for (int q = 0; q < 16; ++q) ss += o[q] * o[q];
        ss += __shfl_xor(ss, 1); ss += __shfl_xor(ss, 2); ss += __shfl_xor(ss, 4);
        const float rstd = 1.0f / sqrtf(ss * (1.f / 128.f) + EPS);
        float y[16];
#pragma unroll
        for (int q = 0; q < 16; ++q) y[q] = o[q] * rstd * nwr[q] * siluf_(z[q]);
        u32x4 w0, w1; w0.x = pk2(y[0], y[1]); w0.y = pk2(y[2], y[3]); w0.z = pk2(y[4], y[5]); w0.w = pk2(y[6], y[7]); w1.x = pk2(y[8], y[9]); w1.y = pk2(y[10], y[11]); w1.z = pk2(y[12], y[13]); w1.w = pk2(y[14], y[15]);
        *(u32x4*)(A1 + (size_t)r * D + 1024 + c0) = w0; *(u32x4*)(A1 + (size_t)r * D + 1024 + c0 + 8) = w1;
#pragma unroll
        for (int j = 0; j < 2; ++j) { a[j] = an[j]; bq[j] = bn[j]; zv[j] = zn[j]; }
    }
}

__device__ __forceinline__ void p4_s5_scan(Frame& F) {
    const float* E = (const float*)(F.ws + WS_E); bf16_t* As5 = (bf16_t*)(F.ws + WS_AS5);
    const bool two = F.G == 256; const int tl = two ? (F.tid & 127) : F.tid;
    for (int gb = two ? (F.bid >= 128 ? 2 * ((int)F.bid - 128) + (F.tid >> 7) : 256) : (int)F.bid; gb < 256; gb += two ? 256 : F.G) {
        if (two ? (F.tid < 256) : (F.tid < 128)) {
            const int g = gb >> 2, b = gb & 3, p = tl & 63, d = tl >> 6;
            const float delta = __expf(F.ap->in[I_LOGSTEP][d * 64 + g]); const float lr = F.ap->in[I_LAMRE][(d * 64 + g) * 64 + p], li = F.ap->in[I_LAMIM][(d * 64 + g) * 64 + p];
            const float mag = expf(16.f * lr * delta); float sn, cs; sincosf(16.f * li * delta, &sn, &cs); const float ar = mag * cs, ai = mag * sn;
            float hr = 0.f, hi = 0.f;
            const size_t rowbase = (size_t)g * S5ROWS + b;
            f32x2 ea[16], eb[16];
#pragma unroll
            for (int q = 0; q < 16; ++q) { const int chunk = d ? 15 - q : q; ea[q] = *(const f32x2*)(E + (rowbase + chunk * 4) * 256 + d * 128 + p * 2); }
#pragma unroll 1
            for (int i0 = 0; i0 < S5CH; i0 += 32) {
#pragma unroll
                for (int q = 0; q < 16; ++q) { const int idx = i0 + 16 + q, chunk = d ? (idx < 16 ? 15 - idx : 287 - idx) : idx; eb[q] = *(const f32x2*)(E + (rowbase + (idx < S5CH ? chunk : 0) * 4) * 256 + d * 128 + p * 2); }
#pragma unroll
                for (int q = 0; q < 16; ++q) { const int idx = i0 + q, chunk = d ? (idx < 16 ? 15 - idx : 287 - idx) : idx;
                    *(unsigned*)(As5 + (rowbase + chunk * 4) * 512 + 256 + d * 128 + p * 2) = pk2(hr, hi);
                    const float nr = ar * hr - ai * hi + ea[q].x, ni = ar * hi + ai * hr + ea[q].y; hr = nr; hi = ni; }
                if (i0 + 16 < S5CH) {
#pragma unroll
                    for (int q = 0; q < 16; ++q) { const int idx = i0 + 32 + q, chunk = d ? (idx < 16 ? 15 - idx : 287 - idx) : idx; ea[q] = *(const f32x2*)(E + (rowbase + (idx < S5CH ? chunk : 0) * 4) * 256 + d * 128 + p * 2); }
#pragma unroll
                    for (int q = 0; q < 16; ++q) { const int idx = i0 + 16 + q, chunk = d ? (idx < 16 ? 15 - idx : 287 - idx) : idx;
                        *(unsigned*)(As5 + (rowbase + chunk * 4) * 512 + 256 + d * 128 + p * 2) = pk2(hr, hi);
                        const float nr = ar * hr - ai * hi + eb[q].x, ni = ar * hi + ai * hr + eb[q].y; hr = nr; hi = ni; }
                }
            }
        }
    }
}

__device__ __forceinline__ int chunk_row0(int b, int n) { return n < 4 ? NL + b * CTXL + 64 * n : b * SEQ + 64 * (n - 4); }
struct GpIn { u32x4 q[4], k[4], lr; float gw[16], gb; };
__device__ __forceinline__ void gp_load(GpIn& in, Frame& F, int item, int c) {
    const bf16_t* P = (const bf16_t*)(F.ws + WS_P);
    const int n = item % NCH, chain = item / NCH, d = chain & 1, h = (chain >> 1) & 3, b = chain >> 3; const int r0 = chunk_row0(b, n);
#pragma unroll
    for (int j = 0; j < 4; ++j) { const int cidx = F.tid + 512 * j, pos = cidx >> 5, cc = cidx & 31; const bf16_t* src = P + (size_t)(r0 + pos) * EINP + h * 256 + cc * 8;
        in.q[j] = *(const u32x4*)src; in.k[j] = *(const u32x4*)(src + 1024); }
    { const int t = F.tid & 127, pos = t >> 1, hf = t & 1; in.lr = *(const u32x4*)(P + (size_t)(r0 + pos) * EINP + 6144 + d * 16 + hf * 8); }
#pragma unroll
    for (int j = 0; j < 16; ++j) in.gw[j] = F.ap->in[I_GLAW2][(d * 16 + j) * 1024 + h * 256 + c];
    in.gb = F.ap->in[I_GLAB][d * 1024 + h * 256 + c];
}
__device__ __forceinline__ void p13_gla_prep(Frame& F) {
    const bf16_t* P = (const bf16_t*)(F.ws + WS_P);
    const int lane = F.lane, w = F.wave;
    {
        const int db = w * 8 + (lane >> 3), pb = lane & 7;
        u32x4 R[8], Rn[8];
        int first = (int)F.bid, step = (int)F.G, end = 1088;
        if (F.G == 256) { if (F.bid < 128) { first = 2 * (int)F.bid; step = 1; end = first + 2; } else { first = 256 + ((int)F.bid - 128); step = 128; end = 1088; } }
        if (first < end) { const int n = first % NCH, bh = first / NCH, h = bh & 3, b = bh >> 2; const int r0 = chunk_row0(b, n);
#pragma unroll
            for (int q = 0; q < 8; ++q) R[q] = *(const u32x4*)(P + (size_t)(r0 + 8 * pb + q) * EINP + 2048 + h * 512 + 8 * db); }
#pragma unroll 1
        for (int item = first; item < end; item += step) {
            { const int nx = item + step < end ? item + step : item; const int n = nx % NCH, bh = nx / NCH, h = bh & 3, b = bh >> 2; const int r0 = chunk_row0(b, n);
#pragma unroll
              for (int q = 0; q < 8; ++q) Rn[q] = *(const u32x4*)(P + (size_t)(r0 + 8 * pb + q) * EINP + 2048 + h * 512 + 8 * db); }
            bf16_t* vt = (bf16_t*)(F.ws + WS_GLV + (size_t)item * GLV_STRIDE);
#pragma unroll
            for (int j = 0; j < 8; ++j) { u32x4 c;
#pragma unroll
                for (int m = 0; m < 4; ++m) { const unsigned lo = R[2 * m][j >> 1], hi = R[2 * m + 1][j >> 1]; c[m] = (j & 1) ? __builtin_amdgcn_perm(hi, lo, 0x07060302u) : __builtin_amdgcn_perm(hi, lo, 0x05040100u); }
                *(u32x4*)(vt + (size_t)(8 * db + j) * 64 + 8 * pb) = c; }
#pragma unroll
            for (int q = 0; q < 8; ++q) R[q] = Rn[q];
        }
    }
    bf16_t* qL = (bf16_t*)F.ldsg;
    bf16_t* kL = (bf16_t*)(F.ldsg + 33792);
    bf16_t* kdT = (bf16_t*)(F.ldsg + 67584);
    float* lrL = (float*)(F.ldsg + 104448);
    float* tot = (float*)(F.ldsg + 108544);
    const int c = F.tid & 255, ph = F.tid >> 8;
    __syncthreads();
    GpIn in;
    if (F.bid < 2176) gp_load(in, F, F.bid, c);
#pragma unroll 1
    for (int item = F.bid; item < 2176; item += F.G) {
        const int n = item % NCH, chain = item / NCH, d = chain & 1; (void)n;
        unsigned char* ob = F.ws + WS_GLB + (size_t)item * GL_STRIDE;
#pragma unroll
        for (int j = 0; j < 4; ++j) { const int cidx = F.tid + 512 * j, pos = cidx >> 5, cc = cidx & 31; *(u32x4*)(qL + pos * 264 + cc * 8) = in.q[j]; *(u32x4*)(kL + pos * 264 + cc * 8) = in.k[j]; }
        if (F.tid < 128) { const int pos = F.tid >> 1, hf = F.tid & 1; const u32x4 v = in.lr; float* dst = lrL + pos * 16 + hf * 8;
            dst[0] = bflo(v.x); dst[1] = bfhi(v.x); dst[2] = bflo(v.y); dst[3] = bfhi(v.y); dst[4] = bflo(v.z); dst[5] = bfhi(v.z); dst[6] = bflo(v.w); dst[7] = bfhi(v.w); }
        float gw[16];
#pragma unroll
        for (int j = 0; j < 16; ++j) gw[j] = in.gw[j];
        const float gb = in.gb;
        gp_load(in, F, item + F.G < 2176 ? item + F.G : item, c);
        WG_BAR();
        float pre[32]; float run = 0.f;
#pragma unroll
        for (int i = 0; i < 32; ++i) { const int pos = 32 * ph + i; float z = gb;
#pragma unroll
            for (int j4 = 0; j4 < 4; ++j4) { const f32x4 l4 = *(const f32x4*)(lrL + pos * 16 + 4 * j4); z += l4[0] * gw[4 * j4] + l4[1] * gw[4 * j4 + 1] + l4[2] * gw[4 * j4 + 2] + l4[3] * gw[4 * j4 + 3]; }
            const float ls = fminf(z, 0.f) - __logf(1.0f + __expf(-fabsf(z))); run += ls * 0.0625f; pre[i] = run; }
        tot[ph * 256 + c] = run;
        WG_BAR();
        const float off = ph ? tot[c] : 0.f; const float cl = tot[c] + tot[256 + c]; const float ecl = __expf(cl);
#pragma unroll
        for (int i8 = 0; i8 < 4; ++i8) { float kd[8];
#pragma unroll
            for (int q = 0; q < 8; ++q) { const int i = 8 * i8 + q, pos = 32 * ph + i;
                const float cv = d ? (cl - (off + pre[i]) + (pre[i] - (i ? pre[i - 1] : 0.f))) : (off + pre[i]);
                const float e = __expf(cv), rcp = __builtin_amdgcn_rcpf(e);
                const float qv = bf1(qL[pos * 264 + c]) * 0.0625f, kv = bf1(kL[pos * 264 + c]);
                qL[pos * 264 + c] = (bf16_t)f2bf(qv * e); const float ki = kv * rcp; kL[pos * 264 + c] = (bf16_t)f2bf(ki); kd[q] = ki * ecl; }
            u32x4 wv; wv.x = pk2(kd[0], kd[1]); wv.y = pk2(kd[2], kd[3]); wv.z = pk2(kd[4], kd[5]); wv.w = pk2(kd[6], kd[7]);
            *(u32x4*)(kdT + c * 72 + 32 * ph + 8 * i8) = wv; }
        if (ph == 0) *(float*)(ob + GL_GL + (size_t)c * 4) = ecl;
        WG_BAR();
        for (int tix = w; tix < 10; tix += 8) { const int ta = tix >= 6 ? 3 : tix >= 3 ? 2 : tix >= 1 ? 1 : 0, tb = tix - ta * (ta + 1) / 2; const int it = d ? tb : ta, jt = d ? ta : tb;
            f32x4 a = {0.f, 0.f, 0.f, 0.f};
#pragma unroll
            for (int kk = 0; kk < 8; ++kk) { const bf16x8 fa = *(const bf16x8*)(kL + (16 * jt + (lane & 15)) * 264 + 32 * kk + 8 * (lane >> 4)); const bf16x8 fb = *(const bf16x8*)(qL + (16 * it + (lane & 15)) * 264 + 32 * kk + 8 * (lane >> 4));
                a = __builtin_amdgcn_mfma_f32_16x16x32_bf16(fa, fb, a, 0, 0, 0); }
            const int i = 16 * it + (lane & 15), j0 = 16 * jt + 4 * (lane >> 4); float o[4];
#pragma unroll
            for (int q = 0; q < 4; ++q) o[q] = (d ? (j0 + q >= i) : (j0 + q <= i)) ? a[q] : 0.f;
            u32x2 wv; wv.x = pk2(o[0], o[1]); wv.y = pk2(o[2], o[3]); *(u32x2*)(ob + GL_ATT + (size_t)(i * 64 + j0) * 2) = wv; }
        if (w < 6) { const int ta = w < 3 ? 0 : w < 5 ? 1 : 2, tb = w < 3 ? w + 1 : w < 5 ? w - 1 : 3; const int it = d ? tb : ta, jt = d ? ta : tb;
            const int i = 16 * it + (lane & 15), j0 = 16 * jt + 4 * (lane >> 4); const u32x2 z = {0u, 0u}; *(u32x2*)(ob + GL_ATT + (size_t)(i * 64 + j0) * 2) = z; }
#pragma unroll
        for (int j = 0; j < 4; ++j) { const int cidx = F.tid + 512 * j; { const int pos = cidx >> 5, cc = cidx & 31; *(u32x4*)(ob + GL_QIN + (size_t)(pos * 256 + cc * 8) * 2) = *(const u32x4*)(qL + pos * 264 + cc * 8); }
            { const int rr = cidx >> 3, cc = cidx & 7; *(u32x4*)(ob + GL_KDT + (size_t)(rr * 64 + cc * 8) * 2) = *(const u32x4*)(kdT + rr * 72 + cc * 8); } }
        WG_BAR();
    }
}
constexpr int GL_LQI = 33792, GL_LKD = 67584, GL_LAT = 104448, GL_LVT = 113664, GL_LGL = 122880, GL_OB = 123904, GL_OBP = 72;
struct GlStage { u32x4 qi[4], kd[4], at, vt, gl; };
__device__ __forceinline__ void gla_stage_load(GlStage& st, const unsigned char* ib, const unsigned char* iv, int sl, int tid) {
    const unsigned o = (unsigned)tid * 16u;
#pragma unroll
    for (int j = 0; j < 4; ++j) { st.qi[j] = *(const u32x4*)(ib + GL_QIN + 8192 * j + o); st.kd[j] = *(const u32x4*)(ib + GL_KDT + 8192 * j + o); }
    st.at = *(const u32x4*)(ib + GL_ATT + o);
    st.vt = *(const u32x4*)(iv + 8192 * sl + o);
    st.gl = *(const u32x4*)(ib + GL_GL + (o & 1023u));
}
__device__ __forceinline__ void gla_stage_store(const GlStage& st, unsigned char* lds, int tid) {
#pragma unroll
    for (int j = 0; j < 4; ++j) { const int cidx = tid + 512 * j; *(u32x4*)(lds + GL_LQI + (cidx >> 5) * 528 + (cidx & 31) * 16) = st.qi[j]; *(u32x4*)(lds + GL_LKD + (cidx >> 3) * 144 + (cidx & 7) * 16) = st.kd[j]; }
    *(u32x4*)(lds + GL_LAT + (tid >> 3) * 144 + (tid & 7) * 16) = st.at;
    *(u32x4*)(lds + GL_LVT + (tid >> 3) * 144 + (tid & 7) * 16) = st.vt;
    if (tid < 64) *(u32x4*)(lds + GL_LGL + tid * 16) = st.gl;
}
__device__ __forceinline__ int gla_chunk(int d, int t) { return d ? (t < 4 ? 3 - t : 71 - t) : t; }
__device__ __forceinline__ void gla_flush(Frame& F, int tlast, int b, int d, int h, int sl) {
    const bf16_t* Ob = (const bf16_t*)(F.ldsg + GL_OB); bf16_t* O = (bf16_t*)(F.ws + WS_OGL);
#pragma unroll
    for (int j = 0; j < 2; ++j) { const int idx = F.tid + 512 * j, c8 = idx & 7, pos = (idx >> 3) & 63, sn = idx >> 9;
        const u32x4 v = *(const u32x4*)(Ob + (sn * 64 + pos) * GL_OBP + 8 * c8); const int r = chunk_row0(b, gla_chunk(d, tlast - 1 + sn)) + pos;
        *(u32x4*)(O + ((size_t)d * NL + r) * D + h * 512 + 64 * sl + 8 * c8) = v; }
}
__device__ __forceinline__ void p14_gla_scan(Frame& F) {
    unsigned char* L = F.ldsg; bf16_t* St = (bf16_t*)L; bf16_t* Ob = (bf16_t*)(L + GL_OB);
    const int w = F.wave, lr = F.lane & 15, lq = F.lane >> 4, pt = w >> 1, cth = w & 1;
    for (int unit0 = F.bid; unit0 < 256; unit0 += F.G) {
        const int unit = (unit0 & 7) * 32 + (unit0 >> 3);
        const int sl = unit & 7, chain = unit >> 3, d = chain & 1, h = (chain >> 1) & 3, b = chain >> 3;
        f32x4 accS[4][2];
#pragma unroll
        for (int a = 0; a < 4; ++a)
#pragma unroll
            for (int c2 = 0; c2 < 2; ++c2) accS[a][c2] = (f32x4){0.f, 0.f, 0.f, 0.f};
        for (int i = F.tid; i < 33792 / 4; i += 512) ((unsigned*)L)[i] = 0u;
        const unsigned char* gb0 = F.ws + WS_GLB + (size_t)(chain * NCH) * GL_STRIDE; const unsigned char* gv0 = F.ws + WS_GLV + (size_t)((chain >> 1) * NCH) * GLV_STRIDE;
        GlStage sgA, sgB;
        { const int n0 = gla_chunk(d, 0), n1 = gla_chunk(d, 1); gla_stage_load(sgA, gb0 + (size_t)n0 * GL_STRIDE, gv0 + (size_t)n0 * GLV_STRIDE, sl, F.tid); gla_stage_load(sgB, gb0 + (size_t)n1 * GL_STRIDE, gv0 + (size_t)n1 * GLV_STRIDE, sl, F.tid); }
#pragma unroll 1
        for (int t = 0; t < NCH; t += 2) {
            {
            gla_stage_store(sgA, L, F.tid);
            if (t >= 6 && (t & 1) == 0) gla_flush(F, t - 1, b, d, h, sl);
            { const int n1 = gla_chunk(d, t + 2 < NCH ? t + 2 : NCH - 1); gla_stage_load(sgA, gb0 + (size_t)n1 * GL_STRIDE, gv0 + (size_t)n1 * GLV_STRIDE, sl, F.tid); }
            WG_BAR();
            if (t >= 4) {
                f32x4 ao[2] = {{0.f, 0.f, 0.f, 0.f}, {0.f, 0.f, 0.f, 0.f}};
#pragma unroll
                for (int kk = 0; kk < 8; ++kk) { const bf16x8 fq = *(const bf16x8*)(L + GL_LQI + (16 * pt + lr) * 528 + 64 * kk + 16 * lq);
#pragma unroll
                    for (int c2 = 0; c2 < 2; ++c2) { const bf16x8 fs = *(const bf16x8*)(St + (16 * (2 * cth + c2) + lr) * 264 + 32 * kk + 8 * lq); ao[c2] = __builtin_amdgcn_mfma_f32_16x16x32_bf16(fq, fs, ao[c2], 0, 0, 0); } }
#pragma unroll
                for (int kk = 0; kk < 2; ++kk) { const bf16x8 fa = *(const bf16x8*)(L + GL_LAT + (16 * pt + lr) * 144 + 64 * kk + 16 * lq);
#pragma unroll
                    for (int c2 = 0; c2 < 2; ++c2) { const bf16x8 fv = *(const bf16x8*)(L + GL_LVT + (16 * (2 * cth + c2) + lr) * 144 + 64 * kk + 16 * lq); ao[c2] = __builtin_amdgcn_mfma_f32_16x16x32_bf16(fa, fv, ao[c2], 0, 0, 0); } }
#pragma unroll
                for (int c2 = 0; c2 < 2; ++c2)
#pragma unroll
                    for (int q = 0; q < 4; ++q) Ob[((t & 1) * 64 + 16 * pt + 4 * lq + q) * GL_OBP + 16 * (2 * cth + c2) + lr] = (bf16_t)f2bf(ao[c2][q]);
            }
            WG_BAR();
            bf16x8 fv[2][2];
#pragma unroll
            for (int c2 = 0; c2 < 2; ++c2)
#pragma unroll
                for (int kk = 0; kk < 2; ++kk) fv[c2][kk] = *(const bf16x8*)(L + GL_LVT + (16 * (2 * cth + c2) + lr) * 144 + 64 * kk + 16 * lq);
#pragma unroll
            for (int a = 0; a < 4; ++a) { const int rt = 4 * pt + a; const f32x4 gl = *(const f32x4*)(L + GL_LGL + (16 * rt + 4 * lq) * 4);
                bf16x8 fk[2];
#pragma unroll
                for (int kk = 0; kk < 2; ++kk) fk[kk] = *(const bf16x8*)(L + GL_LKD + (16 * rt + lr) * 144 + 64 * kk + 16 * lq);
#pragma unroll
                for (int c2 = 0; c2 < 2; ++c2) { accS[a][c2] = accS[a][c2] * gl;
#pragma unroll
                    for (int kk = 0; kk < 2; ++kk) accS[a][c2] = __builtin_amdgcn_mfma_f32_16x16x32_bf16(fk[kk], fv[c2][kk], accS[a][c2], 0, 0, 0);
                    u32x2 sv; sv.x = pk2(accS[a][c2][0], accS[a][c2][1]); sv.y = pk2(accS[a][c2][2], accS[a][c2][3]); *(u32x2*)(St + (16 * (2 * cth + c2) + lr) * 264 + 16 * rt + 4 * lq) = sv; } }
            WG_BAR();
                    }
            {
            gla_stage_store(sgB, L, F.tid);
            if ((t + 1) >= 6 && ((t + 1) & 1) == 0) gla_flush(F, (t + 1) - 1, b, d, h, sl);
            { const int n1 = gla_chunk(d, (t + 1) + 2 < NCH ? (t + 1) + 2 : NCH - 1); gla_stage_load(sgB, gb0 + (size_t)n1 * GL_STRIDE, gv0 + (size_t)n1 * GLV_STRIDE, sl, F.tid); }
            WG_BAR();
            if ((t + 1) >= 4) {
                f32x4 ao[2] = {{0.f, 0.f, 0.f, 0.f}, {0.f, 0.f, 0.f, 0.f}};
#pragma unroll
                for (int kk = 0; kk < 8; ++kk) { const bf16x8 fq = *(const bf16x8*)(L + GL_LQI + (16 * pt + lr) * 528 + 64 * kk + 16 * lq);
#pragma unroll
                    for (int c2 = 0; c2 < 2; ++c2) { const bf16x8 fs = *(const bf16x8*)(St + (16 * (2 * cth + c2) + lr) * 264 + 32 * kk + 8 * lq); ao[c2] = __builtin_amdgcn_mfma_f32_16x16x32_bf16(fq, fs, ao[c2], 0, 0, 0); } }
#pragma unroll
                for (int kk = 0; kk < 2; ++kk) { const bf16x8 fa = *(const bf16x8*)(L + GL_LAT + (16 * pt + lr) * 144 + 64 * kk + 16 * lq);
#pragma unroll
                    for (int c2 = 0; c2 < 2; ++c2) { const bf16x8 fv = *(const bf16x8*)(L + GL_LVT + (16 * (2 * cth + c2) + lr) * 144 + 64 * kk + 16 * lq); ao[c2] = __builtin_amdgcn_mfma_f32_16x16x32_bf16(fa, fv, ao[c2], 0, 0, 0); } }
#pragma unroll
                for (int c2 = 0; c2 < 2; ++c2)
#pragma unroll
                    for (int q = 0; q < 4; ++q) Ob[(((t + 1) & 1) * 64 + 16 * pt + 4 * lq + q) * GL_OBP + 16 * (2 * cth + c2) + lr] = (bf16_t)f2bf(ao[c2][q]);
            }
            WG_BAR();
            bf16x8 fv[2][2];
#pragma unroll
            for (int c2 = 0; c2 < 2; ++c2)
#pragma unroll
                for (int kk = 0; kk < 2; ++kk) fv[c2][kk] = *(const bf16x8*)(L + GL_LVT + (16 * (2 * cth + c2) + lr) * 144 + 64 * kk + 16 * lq);
#pragma unroll
            for (int a = 0; a < 4; ++a) { const int rt = 4 * pt + a; const f32x4 gl = *(const f32x4*)(L + GL_LGL + (16 * rt + 4 * lq) * 4);
                bf16x8 fk[2];
#pragma unroll
                for (int kk = 0; kk < 2; ++kk) fk[kk] = *(const bf16x8*)(L + GL_LKD + (16 * rt + lr) * 144 + 64 * kk + 16 * lq);
#pragma unroll
                for (int c2 = 0; c2 < 2; ++c2) { accS[a][c2] = accS[a][c2] * gl;
#pragma unroll
                    for (int kk = 0; kk < 2; ++kk) accS[a][c2] = __builtin_amdgcn_mfma_f32_16x16x32_bf16(fk[kk], fv[c2][kk], accS[a][c2], 0, 0, 0);
                    u32x2 sv; sv.x = pk2(accS[a][c2][0], accS[a][c2][1]); sv.y = pk2(accS[a][c2][2], accS[a][c2][3]); *(u32x2*)(St + (16 * (2 * cth + c2) + lr) * 264 + 16 * rt + 4 * lq) = sv; } }
            WG_BAR();
                    }
        }
        gla_flush(F, NCH - 1, b, d, h, sl);
        WG_BAR();
    }
}
__device__ __forceinline__ void p15_gla_post(Frame& F) {
    const int gw = F.bid * NWAVES + F.wave, NGW = F.G * NWAVES;
    const int r_beg = (int)(((long long)gw * NL) / NGW), r_end = (int)(((long long)(gw + 1) * NL) / NGW);
    const bf16_t* O = (const bf16_t*)(F.ws + WS_OGL); const bf16_t* P = (const bf16_t*)(F.ws + WS_P); bf16_t* A1 = (bf16_t*)(F.ws + WS_A1B); const float* nw = F.ap->in[I_GLANORM];
    int c8 = 8 * F.lane; asm volatile("" : "+v"(c8));
    float nwr[8];
#pragma unroll
    for (int q = 0; q < 8; ++q) nwr[q] = nw[c8 + q];
    u32x4 a[4], bq[4], rv[4], an[4], bn[4], rn[4];
    if (r_beg < r_end) {
#pragma unroll
        for (int j = 0; j < 4; ++j) { a[j] = *(const u32x4*)(O + (size_t)r_beg * D + 512 * j + c8); bq[j] = *(const u32x4*)(O + ((size_t)NL + r_beg) * D + 512 * j + c8); rv[j] = *(const u32x4*)(P + (size_t)r_beg * EINP + 4096 + 512 * j + c8); }
    }
#pragma unroll 1
    for (int r = r_beg; r < r_end; ++r) {
        { const int rn_ = r + 1 < r_end ? r + 1 : r;
#pragma unroll
          for (int j = 0; j < 4; ++j) { an[j] = *(const u32x4*)(O + (size_t)rn_ * D + 512 * j + c8); bn[j] = *(const u32x4*)(O + ((size_t)NL + rn_) * D + 512 * j + c8); rn[j] = *(const u32x4*)(P + (size_t)rn_ * EINP + 4096 + 512 * j + c8); } }
        float o[32], ss[4];
#pragma unroll
        for (int j = 0; j < 4; ++j) {
            o[8 * j + 0] = bflo(a[j].x) + bflo(bq[j].x); o[8 * j + 1] = bfhi(a[j].x) + bfhi(bq[j].x); o[8 * j + 2] = bflo(a[j].y) + bflo(bq[j].y); o[8 * j + 3] = bfhi(a[j].y) + bfhi(bq[j].y);
            o[8 * j + 4] = bflo(a[j].z) + bflo(bq[j].z); o[8 * j + 5] = bfhi(a[j].z) + bfhi(bq[j].z); o[8 * j + 6] = bflo(a[j].w) + bflo(bq[j].w); o[8 * j + 7] = bfhi(a[j].w) + bfhi(bq[j].w);
            float t = 0.f;
#pragma unroll
            for (int q = 0; q < 8; ++q) t += o[8 * j + q] * o[8 * j + q];
            ss[j] = t; }
#pragma unroll
        for (int j = 0; j < 4; ++j) ss[j] = wave_sum(ss[j]);
#pragma unroll
        for (int j = 0; j < 4; ++j) { const float rstd = 1.0f / sqrtf(ss[j] * (1.f / 512.f) + EPS); float g8[8];
            g8[0] = bflo(rv[j].x); g8[1] = bfhi(rv[j].x); g8[2] = bflo(rv[j].y); g8[3] = bfhi(rv[j].y); g8[4] = bflo(rv[j].z); g8[5] = bfhi(rv[j].z); g8[6] = bflo(rv[j].w); g8[7] = bfhi(rv[j].w);
            float y[8];
#pragma unroll
            for (int q = 0; q < 8; ++q) y[q] = o[8 * j + q] * rstd * nwr[q] * siluf_(g8[q]);
            u32x4 wv; wv.x = pk2(y[0], y[1]); wv.y = pk2(y[2], y[3]); wv.z = pk2(y[4], y[5]); wv.w = pk2(y[6], y[7]); *(u32x4*)(A1 + (size_t)r * D + 512 * j + c8) = wv; }
#pragma unroll
        for (int j = 0; j < 4; ++j) { a[j] = an[j]; bq[j] = bn[j]; rv[j] = rn[j]; }
    }
}

__device__ __forceinline__ void p17_ln_router(Frame& F) {
    const float* MOD = (const float*)(F.ws + WS_MOD) + (size_t)5 * NMOD; const bf16_t* XR = (const bf16_t*)(F.ws + WS_XR); bf16_t* A2 = (bf16_t*)(F.ws + WS_A2B);
    const float* lg = F.ap->in[I_LN1G] + D; const float* lb = F.ap->in[I_LN1B] + D; const float* wrt = (const float*)(F.ws + MOE_RT);
    int* hist = (int*)F.ldsg; float* RTL = (float*)(F.ldsg + 1024);
    for (int i = F.tid; i < 8 * 2048 / 4; i += 512) *(f32x4*)(RTL + 4 * i) = *(const f32x4*)(wrt + 4 * i);
    int l4 = 4 * F.lane; asm volatile("" : "+v"(l4));
    for (int rb = F.bid; rb < 256; rb += F.G) {
        if (F.tid < 8) hist[F.tid] = 0;
        __syncthreads();
        const float* md = MOD + (size_t)(rb >> 6) * NMOD;
        f32x4 P[8], Q[8], v[8]; u32x2 vn[8]; ln_pq(lg, lb, md + 3 * 2048, md + 4 * 2048, l4, P, Q);
        const int r0 = rb * 64 + F.wave * 8;
#pragma unroll
        for (int j = 0; j < 8; ++j) v[j] = pg8::res_cvt(*(const u32x2*)(XR + (size_t)r0 * D + l4 + 256 * j));
#pragma unroll 1
        for (int q = 0; q < 8; ++q) {
            const int r = r0 + q;
            { const bf16_t* xn = XR + (size_t)(r0 + (q < 7 ? q + 1 : q)) * D;
#pragma unroll
              for (int j = 0; j < 8; ++j) vn[j] = *(const u32x2*)(xn + l4 + 256 * j); }
            float mean, rstd; row_stats(v, mean, rstd);
            float lg8[8];
#pragma unroll
            for (int e = 0; e < 8; ++e) lg8[e] = 0.f;
#pragma unroll
            for (int j = 0; j < 8; ++j) { const f32x4 t = (v[j] - mean) * rstd * P[j] + Q[j];
                u32x2 w; w.x = pk2(t[0], t[1]); w.y = pk2(t[2], t[3]); *(u32x2*)(A2 + (size_t)r * D + l4 + 256 * j) = w;
#pragma unroll
                for (int e = 0; e < 8; ++e) { const f32x4 we = *(const f32x4*)(RTL + e * D + l4 + 256 * j); lg8[e] += (t[0] * we[0] + t[1] * we[1]) + (t[2] * we[2] + t[3] * we[3]); } }
#pragma unroll
            for (int e = 0; e < 8; ++e) lg8[e] = wave_sum(lg8[e]);
            int e0 = 0; float l0 = lg8[0];
#pragma unroll
            for (int e = 1; e < 8; ++e) if (lg8[e] > l0) { l0 = lg8[e]; e0 = e; }
            int e1 = -1; float l1 = -3.0e38f;
#pragma unroll
            for (int e = 0; e < 8; ++e) if (e != e0 && lg8[e] > l1) { l1 = lg8[e]; e1 = e; }
            if (e1 < 0) { e1 = (e0 + 1) & 7; l1 = l0; }
            const float ex = __expf(l1 - l0); const float g0 = 1.0f / (1.0f + ex), g1 = ex / (1.0f + ex);
            if (F.lane == 0) { *(f32x2*)((float*)(F.ws + MOE_STATS) + (size_t)r * 2) = (f32x2){mean, rstd}; int* tk = (int*)(F.ws + MOE_TOPK) + (size_t)r * 4; tk[0] = e0; tk[1] = e1; ((float*)tk)[2] = g0; ((float*)tk)[3] = g1; atomicAdd(&hist[e0], 1); atomicAdd(&hist[e1], 1); }
#pragma unroll
            for (int j = 0; j < 8; ++j) v[j] = pg8::res_cvt(vn[j]);
        }
        __syncthreads();
        if (F.tid < 8) ((int*)(F.ws + MOE_HIST))[rb * 8 + F.tid] = hist[F.tid];
        __syncthreads();
    }
}
__device__ __forceinline__ void p18_moe_place(Frame& F) {
    int* sm = (int*)F.ldsg;
    const int* HIST = (const int*)(F.ws + MOE_HIST); const int* TOPK = (const int*)(F.ws + MOE_TOPK); int* DEST = (int*)(F.ws + MOE_DEST); int* TBL = (int*)(F.ws + MOE_TBL);
    const bf16_t* A2 = (const bf16_t*)(F.ws + WS_A2B); bf16_t* XG = (bf16_t*)(F.ws + WS_XG);
    for (int rb = F.bid; rb < 256; rb += F.G) {
        u32x4 v[8][4];
#pragma unroll
        for (int q = 0; q < 8; ++q)
#pragma unroll
            for (int j = 0; j < 4; ++j) v[q][j] = *(const u32x4*)(A2 + (size_t)(rb * 64 + F.wave * 8 + q) * D + 8 * F.lane + 512 * j);
        if (F.tid < 16) sm[F.tid] = 0;
        __syncthreads();
        {
            const int q = F.tid >> 1; const u32x4 hv = *(const u32x4*)(HIST + q * 8 + 4 * (F.tid & 1));
            int t4[4] = {(int)hv.x, (int)hv.y, (int)hv.z, (int)hv.w}, b4[4];
#pragma unroll
            for (int i = 0; i < 4; ++i) b4[i] = q < rb ? t4[i] : 0;
#pragma unroll
            for (int o = 2; o < 64; o <<= 1)
#pragma unroll
                for (int i = 0; i < 4; ++i) { t4[i] += __shfl_xor(t4[i], o); b4[i] += __shfl_xor(b4[i], o); }
            if (F.lane < 2) {
#pragma unroll
                for (int i = 0; i < 4; ++i) { atomicAdd(&sm[4 * F.lane + i], t4[i]); atomicAdd(&sm[8 + 4 * F.lane + i], b4[i]); } }
        }
        __syncthreads();
        if (F.tid == 0) { int ps = 0; for (int e = 0; e < 8; ++e) { sm[24 + e] = ps; sm[16 + e] = ps + sm[8 + e]; ps += (sm[e] + 255) / 256 * 256; }
            if (rb == 0) { int p = 0; for (int e = 0; e < 8; ++e) { const int np = (sm[e] + 255) / 256; for (int q = 0; q < np; ++q) TBL[p++] = e; } TBL[159] = p; } }
        __syncthreads();
        if (F.wave == 0) { const int r = rb * 64 + F.lane; const int e0 = TOPK[r * 4], e1 = TOPK[r * 4 + 1]; int d0 = 0, d1 = 0;
            const unsigned long long lt = (1ull << F.lane) - 1ull;
#pragma unroll
            for (int e = 0; e < 8; ++e) { const unsigned long long m0 = __ballot(e0 == e), m1 = __ballot(e1 == e);
                if (e0 == e) d0 = sm[16 + e] + __popcll(m0 & lt); if (e1 == e) d1 = sm[16 + e] + __popcll(m0) + __popcll(m1 & lt); }
            DEST[r * 2] = d0; DEST[r * 2 + 1] = d1; sm[32 + 2 * F.lane] = d0; sm[32 + 2 * F.lane + 1] = d1; }
        __syncthreads();
#pragma unroll
        for (int q = 0; q < 8; ++q) { const int tl = F.wave * 8 + q; const int d0 = sm[32 + 2 * tl], d1 = sm[32 + 2 * tl + 1];
#pragma unroll
            for (int j = 0; j < 4; ++j) { *(u32x4*)(XG + (size_t)d0 * D + 8 * F.lane + 512 * j) = v[q][j]; *(u32x4*)(XG + (size_t)d1 * D + 8 * F.lane + 512 * j) = v[q][j]; } }
        __syncthreads();
    }
}
__device__ __forceinline__ void p21_final(Frame& F) {
    const int gw = F.bid * NWAVES + F.wave, NGW = F.G * NWAVES;
    const float* MOD = (const float*)(F.ws + WS_MOD) + (size_t)5 * NMOD; const bf16_t* XR = (const bf16_t*)(F.ws + WS_XR); const bf16_t* YG = (const bf16_t*)(F.ws + WS_YG);
    const int* TOPK = (const int*)(F.ws + MOE_TOPK); const int* DEST = (const int*)(F.ws + MOE_DEST); const float* lg = F.ap->in[I_LN2G] + D; const float* lb = F.ap->in[I_LN2B] + D;
    int l4 = 4 * F.lane; asm volatile("" : "+v"(l4));
    f32x4 LG[8], LB[8];
#pragma unroll
    for (int j = 0; j < 8; ++j) { LG[j] = *(const f32x4*)(lg + l4 + 256 * j); LB[j] = *(const f32x4*)(lb + l4 + 256 * j); }
#pragma unroll 1
    for (int r = gw; r < NL; r += NGW) {
        const float g0 = ((const float*)TOPK)[r * 4 + 2], g1 = ((const float*)TOPK)[r * 4 + 3]; const int d0 = DEST[r * 2], d1 = DEST[r * 2 + 1]; const float* md = MOD + (size_t)(r >> 12) * NMOD + 5 * 2048;
        f32x4 v[8];
        const f32x2 st3 = *(const f32x2*)((const float*)(F.ws + MOE_STATS) + (size_t)r * 2); const float* lg1 = F.ap->in[I_LN1G] + D; const float* lb1 = F.ap->in[I_LN1B] + D;
#pragma unroll
        for (int j = 0; j < 8; ++j) { const int c = l4 + 256 * j; const f32x4 x = (pg8::res_cvt(*(const u32x2*)(XR + (size_t)r * D + c)) - st3.x) * st3.y * *(const f32x4*)(lg1 + c) + *(const f32x4*)(lb1 + c), gt = *(const f32x4*)(md + c);
            const u32x2 a0 = *(const u32x2*)(YG + (size_t)d0 * D + c), a1 = *(const u32x2*)(YG + (size_t)d1 * D + c);
            const f32x4 y0 = {bflo(a0.x), bfhi(a0.x), bflo(a0.y), bfhi(a0.y)}, y1 = {bflo(a1.x), bfhi(a1.x), bflo(a1.y), bfhi(a1.y)};
            v[j] = x * ALPHA + gt * (y0 * g0 + y1 * g1); }
        float mean, rstd; row_stats(v, mean, rstd);
#pragma unroll
        for (int j = 0; j < 8; ++j) { const int c = l4 + 256 * j; *(f32x4*)(F.out + (size_t)r * D + c) = (v[j] - mean) * rstd * LG[j] + LB[j]; }
    }
}


__device__ __forceinline__ void combine_tail(Frame& F, const bf16_t* PART, int U, int S, int pm0, int nN, float* Y, int mode, const float* res, size_t res_row0, const float* gate) {
    const size_t nvec = (size_t)U * 16384;
    for (size_t v = (size_t)F.bid * 512 + F.tid; v < nvec; v += (size_t)F.G * 512) {
        const int u = (int)(v >> 14), rem = (int)(v & 16383), r = rem >> 6, c4 = rem & 63;
        f32x4 sum = {0.f, 0.f, 0.f, 0.f};
        for (int sx = 0; sx < S; ++sx) sum += pg8::res_cvt(*(const u32x2*)(PART + ((size_t)(u * S + sx) * 256 + r) * 256 + 4 * c4));
        const size_t row = (size_t)(pm0 + u / nN) * 256 + r; const int col = (u % nN) * 256 + 4 * c4;
        if (mode == 2) { u32x2 w; w.x = pk2(sum[0], sum[1]); w.y = pk2(sum[2], sum[3]); *(u32x2*)((bf16_t*)Y + row * D + col) = w; continue; }
        if (mode == 1) { const f32x4 rv = *(const f32x4*)(res + (row - res_row0) * D + col), gv = *(const f32x4*)(gate + col); sum = rv * ALPHA + gv * sum; }
        if (mode == 3) { const f32x2 st = *(const f32x2*)((const float*)(F.ws + MOE_STATS) + row * 2); const f32x4 rv = (pg8::res_cvt(*(const u32x2*)((const bf16_t*)res + (row - res_row0) * D + col)) - st.x) * st.y * *(const f32x4*)(F.ap->in[I_LN1G] + col) + *(const f32x4*)(F.ap->in[I_LN1B] + col);
            sum = rv * ALPHA + *(const f32x4*)(gate + col) * sum; }
        { u32x2 w; w.x = pk2(sum[0], sum[1]); w.y = pk2(sum[2], sum[3]); *(u32x2*)((bf16_t*)Y + row * D + col) = w; }
    }
}
constexpr int N_PHASES = 25;
__global__ void __launch_bounds__(NWAVES * 64, 2) fwd_kernel(Args args) {
    extern __shared__ __attribute__((aligned(16))) unsigned char lds[];
    Frame F;
    F.lds = (LAS unsigned char*)lds; F.ldsg = lds;
    F.tid = threadIdx.x; F.lane = F.tid & 63; F.wave = __builtin_amdgcn_readfirstlane(F.tid >> 6);
    F.G = gridDim.x; F.bid = blockIdx.x; F.out = args.out; F.ws = args.ws; F.ap = &args;
    volatile LAS unsigned* MISC = (volatile LAS unsigned*)(F.lds + MISC_OFF);
    if (F.tid < 32) MISC[F.tid] = 0u;
    __syncthreads();
    XcdBarrier bar; bar.bar = (unsigned*)(F.ws + WS_CTL) + CW_BAR; bar.x = 0; bar.st = nullptr;
    const bool one_launch = (args.ph_hi - args.ph_lo) > 1;
    if (one_launch) bar = xcd_barrier_post((unsigned*)(F.ws + WS_CTL) + CW_BAR, MISC + 8);
    const int lo = args.ph_lo, hi = args.ph_hi;
#ifndef PHASE_MASK
#define PHASE_MASK 0xFFFFFFFFu
#endif
#define IN(k) (((PHASE_MASK >> (k)) & 1u) && lo <= (k) && (k) < hi)
#define SEAM(k) do { if (IN(k) && IN((k) + 1)) xcd_barrier(bar); } while (0)
#ifndef PROBE_REP
#define PROBE_REP 0u
#endif
#define PH(k, ...) if (IN(k)) { __VA_ARGS__ if ((PROBE_REP >> (k)) & 1u) { xcd_barrier(bar); __VA_ARGS__ } } SEAM(k);
    unsigned char* ws = F.ws;
    const float* MOD = (const float*)(ws + WS_MOD);

    PH(0, p0_prologue(F);)
    PH(1, p1_modulate(F);)
    PH(2,
        pg8::Gemm g{D, D, D}; pg8::SchedDense S; S.init(ws + WS_A0, ws + WS_WIN0, D, D, MT / 256, EINP / 256, F.G, F.bid);
        pg8::EpiP0 E{(bf16_t*)(ws + WS_P), (bf16_t*)(ws + WS_AS5)};
        pg8::gemm_phase(F.lds, g, S, E);
        if (F.G == 256) tail_convert(F, TB2, TQ2, (int)F.bid - 164);)
    PH(3,
        p3_dn_conv(F);
        __syncthreads();
        pg8::Gemm g{512, 256, 256}; pg8::SchedGroup S; S.init(ws + WS_AS5, ws + WS_S5W, 512, 256, (size_t)256 * 256 * 2, nullptr, 5, 320, 1, F.G, F.bid);
        pg8::EpiF32 E{(float*)(ws + WS_E), 256};
        pg8::gemm_phase(F.lds, g, S, E);)
    PH(4, p4_s5_scan(F); __syncthreads(); p4_dn_prep(F);)
    PH(5,
        const bool split = (F.G == 256); const int gG = split ? 128 : F.G, gC = split ? F.bid - 128 : F.bid;
        if (!split || F.bid >= 128) { pg8::Gemm g{512, 512, 512}; pg8::SchedGroup S; S.init(ws + WS_AS5, ws + WS_S5M, 512, 512, (size_t)256 * 512 * 2, nullptr, 5, 320, 1, gG, gC);
          pg8::EpiS5C E{(const bf16_t*)(ws + WS_P), (bf16_t*)(ws + WS_A1), F.ap->in[I_S5D]};
          pg8::gemm_phase(F.lds, g, S, E); }
        __syncthreads();
        if (!split || F.bid < 128) p5_dn_scan(F, split ? 128 : F.G, F.bid);)
    PH(6, p6_dn_post(F);)
    PH(7,
        { pg8::Gemm g{D, D, D}; pg8::SchedDense S; S.init(ws + WS_A1, ws + WS_WOUT0, D, D, NL / 256, D / 256, F.G, F.bid);
          pg8::EpiYF E{F.ap->in[I_X], F.ap->in[I_CTX], (bf16_t*)(ws + WS_XR), MOD + 2 * 2048};
          pg8::gemm_phase(F.lds, g, S, E); }
        { pg8::Gemm g{D, D, 256}; pg8::SchedSplit S; S.init(ws + WS_A1, ws + WS_WOUT0, D, D, 0, nullptr, NL / 256, D / 256, 32, 8, 256, F.G, F.bid);
          pg8::EpiBf E{(bf16_t*)(ws + WS_P), 256};
          pg8::gemm_phase(F.lds, g, S, E); })
    PH(8, combine_tail(F, (const bf16_t*)(ws + WS_P), 32, 8, NL / 256, D / 256, (float*)(ws + WS_XR), 1, F.ap->in[I_CTX], NL, MOD + 2 * 2048 + (size_t)4 * NMOD);)
    PH(9, ln_mod_rows(F, MT, F.ap->in[I_LN1G], F.ap->in[I_LN1B], 0, 3, 4, (bf16_t*)(ws + WS_A0));)
    PH(10,
        pg8::Gemm g{D, D, D}; pg8::SchedDense S; S.init(ws + WS_A0, ws + WS_W130, D, D, MT / 256, 2 * FFH / 256, F.G, F.bid);
        pg8::EpiH E{(bf16_t*)(ws + WS_H0), FFH};
        pg8::gemm_phase(F.lds, g, S, E);
        if (F.G == 256) tail_convert(F, TB9, TQ9, (int)F.bid - 176);)
    PH(11,
        const bf16_t* xr = (const bf16_t*)(ws + WS_XR);
        { pg8::Gemm g{FFH, FFH, FFH}; pg8::SchedDense S; S.init(ws + WS_H0, ws + WS_W20, FFH, FFH, NL / 256, D / 256, F.G, F.bid);
          pg8::EpiYB E{xr, xr + (size_t)NL * D, (bf16_t*)(ws + WS_XR), MOD + 5 * 2048, (const float*)(ws + MOE_STATS), F.ap->in[I_LN1G], F.ap->in[I_LN1B]};
          pg8::gemm_phase(F.lds, g, S, E); }
        { pg8::Gemm g{FFH, FFH, 1408}; pg8::SchedSplit S; S.init(ws + WS_H0, ws + WS_W20, FFH, FFH, 0, nullptr, NL / 256, D / 256, 32, 4, 1408, F.G, F.bid);
          pg8::EpiBf E{(bf16_t*)(ws + WS_P), 256};
          pg8::gemm_phase(F.lds, g, S, E); }
        if (F.G == 256) tail_convert(F, TB10, TQ10, (int)F.bid - 128);)
    PH(12, combine_tail(F, (const bf16_t*)(ws + WS_P), 32, 4, NL / 256, D / 256, (float*)(ws + WS_XR), 3, (const float*)(ws + WS_XR), 0, MOD + 5 * 2048 + (size_t)4 * NMOD);)
    PH(13, ln_mod_rows(F, MT, F.ap->in[I_LN2G], F.ap->in[I_LN2B], 1, 0, 1, (bf16_t*)(ws + WS_A0));)
    PH(14,
        pg8::Gemm g{D, D, D}; pg8::SchedDense S; S.init(ws + WS_A0, ws + WS_WIN1, D, D, MT / 256, EINP / 256, F.G, F.bid);
        pg8::EpiBf E{(bf16_t*)(ws + WS_P), EINP};
        pg8::gemm_phase(F.lds, g, S, E);
        if (F.G == 256) tail_convert(F, TB12, TQ12, (int)F.bid - 164);)
    PH(15, p13_gla_prep(F);)
    PH(16, p14_gla_scan(F);)
    PH(17, p15_gla_post(F);)
    PH(18,
        pg8::Gemm g{D, D, D}; pg8::SchedDense S; S.init(ws + WS_A1B, ws + WS_WOUT1, D, D, NL / 256, D / 256, F.G, F.bid);
        const bf16_t* xr = (const bf16_t*)(ws + WS_XR);
        pg8::EpiYB E{xr, xr + (size_t)NL * D, (bf16_t*)(ws + WS_XR), MOD + (size_t)5 * NMOD + 2 * 2048, (const float*)(ws + MOE_STATS), F.ap->in[I_LN2G], F.ap->in[I_LN2B]};
        pg8::gemm_phase(F.lds, g, S, E);)
    PH(19, p17_ln_router(F);)
    PH(20, p18_moe_place(F);)
    PH(21,
        const int* TBL = (const int*)(ws + MOE_TBL); int nP = TBL[159]; nP = nP < 0 ? 0 : (nP > MOE_MAXP ? MOE_MAXP : nP);
        pg8::Gemm g{D, D, D}; pg8::SchedGroup S; S.init(ws + WS_XG, ws + WS_W13M, D, D, (size_t)2 * EXH * D * 2, TBL, 1, nP, 2 * EXH / 256, F.G, F.bid);
        pg8::EpiH E{(bf16_t*)(ws + WS_HM), EXH};
        pg8::gemm_phase(F.lds, g, S, E);)
    PH(22,
        const int* TBL = (const int*)(ws + MOE_TBL); int nP = TBL[159]; nP = nP < 0 ? 0 : (nP > MOE_MAXP ? MOE_MAXP : nP);
        { pg8::Gemm g{EXH, EXH, EXH}; pg8::SchedGroup S; S.init(ws + WS_HM, ws + WS_W2M, EXH, EXH, (size_t)D * EXH * 2, TBL, 1, 128, D / 256, F.G, F.bid);
          pg8::EpiBf E{(bf16_t*)(ws + WS_YG), D};
          pg8::gemm_phase(F.lds, g, S, E); }
        if (nP > 128) { pg8::Gemm g{EXH, EXH, 896}; pg8::SchedSplit S; S.init(ws + WS_HM, ws + WS_W2M, EXH, EXH, (size_t)D * EXH * 2, TBL, 128, D / 256, (nP - 128) * 8, 8, 896, F.G, F.bid);
          pg8::EpiBf E{(bf16_t*)(ws + WS_XG), 256};
          pg8::gemm_phase(F.lds, g, S, E); })
    PH(23, const int* TBL = (const int*)(ws + MOE_TBL); int nP = TBL[159]; nP = nP < 128 ? 128 : (nP > MOE_MAXP ? MOE_MAXP : nP);
        combine_tail(F, (const bf16_t*)(ws + WS_XG), (nP - 128) * 8, 8, 128, D / 256, (float*)(ws + WS_YG), 2, nullptr, 0, nullptr);)
    PH(24, p21_final(F);)
#undef IN
#undef SEAM
#undef PH
}

extern "C" void kernel_launch(void* const* d_in, const int* in_sizes, int n_in, void* d_out, int out_size, void* d_ws, size_t ws_size, hipStream_t stream) {
    static int grid = 0;
    if (grid == 0) {
        if (n_in != 36 || out_size != NL * D || ws_size < WS_END) { fprintf(stderr, "kernel_launch: unexpected problem (n_in %d, out %d, ws %zu < %zu)\n", n_in, out_size, ws_size, (size_t)WS_END); grid = -1; return; }
        int dev = 0, cus = 0, per_cu = 0;
        if (hipGetDevice(&dev) != hipSuccess || hipDeviceGetAttribute(&cus, hipDeviceAttributeMultiprocessorCount, dev) != hipSuccess) { grid = -1; return; }
        if (hipFuncSetAttribute((const void*)fwd_kernel, hipFuncAttributeMaxDynamicSharedMemorySize, LDS_BYTES) != hipSuccess) { fprintf(stderr, "kernel_launch: hipFuncSetAttribute failed\n"); grid = -1; return; }
        if (hipOccupancyMaxActiveBlocksPerMultiprocessor(&per_cu, (const void*)fwd_kernel, NWAVES * 64, LDS_BYTES) != hipSuccess || per_cu < 1) fprintf(stderr, "kernel_launch: occupancy query reports %d\n", per_cu);
        (void)hipGetLastError();
        grid = cus;
    }
    if (grid < 0) return;
    if (hipMemsetAsync((char*)d_ws + WS_CTL, 0, CTL_ZERO_BYTES, stream) != hipSuccess) return;
    Args a{};
    for (int i = 0; i < 36; ++i) a.in[i] = (const float*)d_in[i];
    a.out = (float*)d_out; a.ws = (unsigned char*)d_ws;
#if MK_LAUNCHES == 1
    a.ph_lo = 0; a.ph_hi = N_PHASES;
    hipLaunchKernelGGL(fwd_kernel, dim3(grid), dim3(NWAVES * 64), LDS_BYTES, stream, a);
#else
    for (int p = 0; p < N_PHASES; ++p) { a.ph_lo = p; a.ph_hi = p + 1; hipLaunchKernelGGL(fwd_kernel, dim3(grid), dim3(NWAVES * 64), LDS_BYTES, stream, a); }
#endif
}
```
